# Optimizing an MI355X kernel written in HIP

```python
import math
import jax, jax.numpy as jnp
from jax import lax
import numpy as np

D_MODEL = 1024
BATCH = 8
SEQ = 2048
DEPTH = 1

N_HEADS_ATTN = 8
N_KV_HEADS = 2
HEAD_DIM_ATTN = 64
ATTN_GROUP = N_HEADS_ATTN // N_KV_HEADS
WINDOW = 128
ATTN_BLOCK = WINDOW
N_REL_BUCKETS = 32
REL_MAX_DISTANCE = 128
N_HEADS_MLSTM = 4
HEAD_DIM_MLSTM = 128
MLSTM_CHUNK = 64
CONV_WIDTH = 5
ATTN_Q_W = N_HEADS_ATTN * HEAD_DIM_ATTN
ATTN_KV_W = N_KV_HEADS * HEAD_DIM_ATTN
MLSTM_W = N_HEADS_MLSTM * HEAD_DIM_MLSTM
MLSTM_GATE_W = 2 * 2 * N_HEADS_MLSTM
MERGE_W = 2 * D_MODEL
IN_SPLITS = (ATTN_Q_W, ATTN_KV_W, ATTN_KV_W, MLSTM_W, MLSTM_W, MLSTM_W, MLSTM_W, MLSTM_GATE_W, MERGE_W)
D_IN_PROJ = sum(IN_SPLITS)
N_GROUPS = 4
EXPERTS_PER_GROUP = 8
N_EXPERTS = N_GROUPS * EXPERTS_PER_GROUP
TOP_K_EXPERT = 2
D_EXPERT = 512
MOE_BLOCK = 128
RMS_EPS = 1e-6
NEG_INF = -1e30

kernel_name = "hybrid_gqa_mlstm_hiermoe_encoder"


def rmsnorm(x, g):
    xf = x.astype(jnp.float32)
    y = xf * lax.rsqrt(jnp.mean(xf * xf, axis=-1, keepdims=True) + RMS_EPS)
    return (y * g.astype(jnp.float32)).astype(x.dtype)


def split_cols(t, sizes):
    outs, start = [], 0
    for s in sizes:
        outs.append(t[..., start:start + s])
        start += s
    return outs


def t5_bucket(rel):
    half = N_REL_BUCKETS // 2
    max_exact = half // 2
    sign = jnp.where(rel > 0, half, 0)
    n = jnp.abs(rel)
    nf = jnp.maximum(n, 1).astype(jnp.float32)
    large = max_exact + (jnp.log(nf / max_exact) / math.log(REL_MAX_DISTANCE / max_exact)
                         * (half - max_exact)).astype(jnp.int32)
    large = jnp.minimum(large, half - 1)
    return sign + jnp.where(n < max_exact, n, large)


def band_windows(t, nb):
    B = t.shape[0]
    tp = jnp.pad(t, ((0, 0), (ATTN_BLOCK, ATTN_BLOCK), (0, 0), (0, 0)))
    tp = tp.reshape(B, nb + 2, ATTN_BLOCK, t.shape[2], t.shape[3])
    return jnp.concatenate([tp[:, :-2], tp[:, 1:-1], tp[:, 2:]], axis=2)


def windowed_gqa(q, k, v, q_gain, k_gain, rel_table, sink):
    B, S = q.shape[0], q.shape[1]
    nb = S // ATTN_BLOCK
    q = q.reshape(B, S, N_HEADS_ATTN, HEAD_DIM_ATTN)
    k = k.reshape(B, S, N_KV_HEADS, HEAD_DIM_ATTN)
    v = v.reshape(B, S, N_KV_HEADS, HEAD_DIM_ATTN)
    q = rmsnorm(q, q_gain) * (HEAD_DIM_ATTN ** -0.5)
    k = rmsnorm(k, k_gain)
    qb = q.reshape(B, nb, ATTN_BLOCK, N_KV_HEADS, ATTN_GROUP, HEAD_DIM_ATTN)
    kw = band_windows(k, nb)
    vw = band_windows(v, nb)
    scores = jnp.einsum('bnqkgd,bnskd->bkgnqs', qb, kw).astype(jnp.float32)
    qi = jnp.arange(ATTN_BLOCK)
    ks = jnp.arange(3 * ATTN_BLOCK) - ATTN_BLOCK
    rel = ks[None, :] - qi[:, None]
    bias = jnp.transpose(rel_table[t5_bucket(rel)].astype(jnp.float32), (2, 0, 1))
    bias = bias.reshape(N_KV_HEADS, ATTN_GROUP, 1, ATTN_BLOCK, 3 * ATTN_BLOCK)
    kpos = jnp.arange(nb)[:, None, None] * ATTN_BLOCK + ks[None, None, :]
    valid = (jnp.abs(rel) <= WINDOW)[None] & (kpos >= 0) & (kpos < S)
    scores = jnp.where(valid, scores + bias, NEG_INF)
    sink_col = jnp.broadcast_to(sink.astype(jnp.float32).reshape(N_KV_HEADS, ATTN_GROUP, 1, 1, 1),
                                scores.shape[:-1] + (1,))
    probs = jax.nn.softmax(jnp.concatenate([scores, sink_col], axis=-1), axis=-1)[..., :-1]
    out = jnp.einsum('bkgnqs,bnskd->bnqkgd', probs.astype(v.dtype), vw)
    return out.reshape(B, S, ATTN_Q_W)


def mlstm_scan(q, k, v, ig, lf):
    B, H, S, d = q.shape
    L = MLSTM_CHUNK
    nc = S // L

    def chunks(t):
        return jnp.moveaxis(t.reshape((B, H, nc, L) + t.shape[3:]), 2, 0)

    tril = jnp.tril(jnp.ones((L, L), dtype=bool))

    def step(carry, inp):
        C, n, m = carry
        qc, kc, vc, igc, lfc = inp
        b = jnp.cumsum(lfc, axis=-1)
        dlog = jnp.where(tril, b[..., :, None] - b[..., None, :] + igc[..., None, :], -jnp.inf)
        g_inter = b + m[..., None]
        m_row = jnp.maximum(g_inter, jnp.max(dlog, axis=-1))
        w = jnp.exp(dlog - m_row[..., None])
        s = jnp.einsum('bhtd,bhsd->bhts', qc, kc) * w
        inter = jnp.exp(g_inter - m_row)
        num = jnp.einsum('bhts,bhsd->bhtd', s, vc) + inter[..., None] * jnp.einsum('bhtd,bhde->bhte', qc, C)
        den = jnp.sum(s, axis=-1) + inter * jnp.einsum('bhtd,bhd->bht', qc, n)
        h = num / jnp.maximum(jnp.abs(den), jnp.exp(-m_row))[..., None]
        b_last = b[..., -1]
        wlog = b_last[..., None] - b + igc
        m_new = jnp.maximum(b_last + m, jnp.max(wlog, axis=-1))
        decay = jnp.exp(b_last + m - m_new)
        ws = jnp.exp(wlog - m_new[..., None])
        C_new = decay[..., None, None] * C + jnp.einsum('bhs,bhsd,bhse->bhde', ws, kc, vc)
        n_new = decay[..., None] * n + jnp.einsum('bhs,bhsd->bhd', ws, kc)
        return (C_new, n_new, m_new), h

    init = (jnp.zeros((B, H, d, d), jnp.float32), jnp.zeros((B, H, d), jnp.float32),
            jnp.zeros((B, H), jnp.float32))
    _, h = lax.scan(step, init, (chunks(q), chunks(k), chunks(v), chunks(ig), chunks(lf)))
    return jnp.moveaxis(h, 0, 2).reshape(B, H, S, d)


def mlstm_branch(qm, km, vm, om, gates, conv_w, conv_b, gate_b, out_gain):
    B, S = qm.shape[0], qm.shape[1]
    qk = jnp.concatenate([qm, km], axis=-1)
    qk = lax.conv_general_dilated(qk, conv_w[:, None, :].astype(qk.dtype), (1,),
                                  [(CONV_WIDTH // 2, CONV_WIDTH // 2)],
                                  dimension_numbers=('NWC', 'WIO', 'NWC'),
                                  feature_group_count=qk.shape[-1]) + conv_b
    qk = jax.nn.silu(qk)
    qm, km = qk[..., :MLSTM_W], qk[..., MLSTM_W:]

    def heads(t):
        return t.reshape(B, S, N_HEADS_MLSTM, HEAD_DIM_MLSTM).transpose(0, 2, 1, 3).astype(jnp.float32)

    q = heads(qm)
    k = heads(km) * (HEAD_DIM_MLSTM ** -0.5)
    v = heads(vm)
    g = gates.astype(jnp.float32).reshape(B, S, 2, 2, N_HEADS_MLSTM) + gate_b.astype(jnp.float32)
    g = jnp.transpose(g, (2, 3, 0, 4, 1))
    h_f = mlstm_scan(q, k, v, g[0, 0], jax.nn.log_sigmoid(g[0, 1]))

    def flip(t):
        return jnp.flip(t, axis=2)

    h_b = flip(mlstm_scan(flip(q), flip(k), flip(v), flip(g[1, 0]), flip(jax.nn.log_sigmoid(g[1, 1]))))
    h = (h_f + h_b).transpose(0, 2, 1, 3)
    h = rmsnorm(h, out_gain)
    return h.reshape(B, S, MLSTM_W).astype(om.dtype) * jax.nn.sigmoid(om)


def hier_moe(h, w_rg, b_rg, w_re, b_re, w_gate, w_up, w_down):
    B, S, D = h.shape
    T = B * S
    xt = h.reshape(T, D)
    xf = xt.astype(jnp.float32)
    g_logits = xf @ w_rg.astype(jnp.float32) + b_rg.astype(jnp.float32)
    g_idx = jnp.argmax(g_logits, axis=-1).astype(jnp.int32)
    p_group = jnp.take_along_axis(jax.nn.softmax(g_logits, axis=-1), g_idx[:, None], axis=1)[:, 0]
    e_logits = (xf @ w_re.astype(jnp.float32) + b_re.astype(jnp.float32)).reshape(T, N_GROUPS, EXPERTS_PER_GROUP)
    e_in = jnp.take_along_axis(e_logits, g_idx[:, None, None], axis=1)[:, 0]
    top_v, top_i = lax.top_k(e_in, TOP_K_EXPERT)
    top_w = jax.nn.softmax(top_v, axis=-1) * p_group[:, None]
    expert_ids = (g_idx[:, None] * EXPERTS_PER_GROUP + top_i).reshape(-1).astype(jnp.int32)
    weights = top_w.reshape(-1)
    token_ids = jnp.repeat(jnp.arange(T, dtype=jnp.int32), TOP_K_EXPERT)
    A = T * TOP_K_EXPERT
    order = jnp.argsort(expert_ids)
    se, stok, sw = expert_ids[order], token_ids[order], weights[order]
    counts = jnp.bincount(expert_ids, length=N_EXPERTS)
    starts = jnp.cumsum(counts) - counts
    pcounts = ((counts + MOE_BLOCK - 1) // MOE_BLOCK) * MOE_BLOCK
    pends = jnp.cumsum(pcounts)
    pstarts = pends - pcounts
    dest = pstarts[se] + (jnp.arange(A, dtype=jnp.int32) - starts[se])
    P = A + N_EXPERTS * MOE_BLOCK
    nblk = P // MOE_BLOCK
    row_tok = jnp.zeros((P,), jnp.int32).at[dest].set(stok)
    row_w = jnp.zeros((P,), jnp.float32).at[dest].set(sw)
    blk_e = jnp.minimum(jnp.searchsorted(pends, jnp.arange(nblk) * MOE_BLOCK, side='right'),
                        N_EXPERTS - 1).astype(jnp.int32)
    xs = xt[row_tok].reshape(nblk, MOE_BLOCK, D)

    def expert_block(args):
        xb, e = args
        return (jax.nn.silu(xb @ w_gate[e]) * (xb @ w_up[e])) @ w_down[e]

    ys = lax.map(expert_block, (xs, blk_e)).reshape(P, D)
    y = jnp.zeros((T, D), ys.dtype).at[row_tok].add(ys * row_w[:, None].astype(ys.dtype))
    return y.reshape(B, S, D).astype(h.dtype)


def setup_inputs(seed: int = 0) -> dict:
    key = jax.random.key(seed)
    ks = jax.random.split(key, 24)

    def nrm(k, shape, scale):
        return jax.random.normal(k, shape, jnp.float32) * scale

    ib = nrm(ks[9], (DEPTH, 2, 1, N_HEADS_MLSTM), 0.1)
    fb = jnp.linspace(3.0, 6.0, N_HEADS_MLSTM, dtype=jnp.float32)[None, None, None, :] + nrm(ks[10], (DEPTH, 2, 1, N_HEADS_MLSTM), 0.01)
    return {
        'x': nrm(ks[0], (BATCH, SEQ, D_MODEL), 1.0),
        'norm1_g': 1.0 + nrm(ks[1], (DEPTH, D_MODEL), 0.01),
        'w_in': nrm(ks[2], (DEPTH, D_MODEL, D_IN_PROJ), D_MODEL ** -0.5),
        'attn_q_gain': 1.0 + nrm(ks[3], (DEPTH, HEAD_DIM_ATTN), 0.01),
        'attn_k_gain': 1.0 + nrm(ks[4], (DEPTH, HEAD_DIM_ATTN), 0.01),
        'attn_sink': nrm(ks[5], (DEPTH, N_HEADS_ATTN), 0.5),
        'rel_bias_table': nrm(ks[6], (N_REL_BUCKETS, N_HEADS_ATTN), 0.5),
        'mlstm_conv_w': nrm(ks[7], (DEPTH, CONV_WIDTH, 2 * MLSTM_W), CONV_WIDTH ** -0.5),
        'mlstm_conv_b': nrm(ks[8], (DEPTH, 2 * MLSTM_W), 0.01),
        'mlstm_gate_b': jnp.concatenate([ib, fb], axis=2),
        'mlstm_out_gain': 1.0 + nrm(ks[11], (DEPTH, N_HEADS_MLSTM, HEAD_DIM_MLSTM), 0.01),
        'w_branch_attn': nrm(ks[12], (DEPTH, ATTN_Q_W, D_MODEL), ATTN_Q_W ** -0.5),
        'w_branch_mlstm': nrm(ks[13], (DEPTH, MLSTM_W, D_MODEL), MLSTM_W ** -0.5),
        'merge_b': nrm(ks[14], (DEPTH, MERGE_W), 0.01),
        'w_out': nrm(ks[15], (DEPTH, D_MODEL, D_MODEL), D_MODEL ** -0.5),
        'norm2_g': 1.0 + nrm(ks[16], (DEPTH, D_MODEL), 0.01),
        'w_router_group': nrm(ks[17], (DEPTH, D_MODEL, N_GROUPS), D_MODEL ** -0.5),
        'b_router_group': nrm(ks[18], (DEPTH, N_GROUPS), 0.01),
        'w_router_expert': nrm(ks[19], (DEPTH, D_MODEL, N_EXPERTS), D_MODEL ** -0.5),
        'b_router_expert': nrm(ks[20], (DEPTH, N_EXPERTS), 0.01),
        'w_expert_gate': nrm(ks[21], (DEPTH, N_EXPERTS, D_MODEL, D_EXPERT), D_MODEL ** -0.5),
        'w_expert_up': nrm(ks[22], (DEPTH, N_EXPERTS, D_MODEL, D_EXPERT), D_MODEL ** -0.5),
        'w_expert_down': nrm(ks[23], (DEPTH, N_EXPERTS, D_EXPERT, D_MODEL), D_EXPERT ** -0.5),
    }


def reference(x, norm1_g, w_in, attn_q_gain, attn_k_gain, attn_sink, rel_bias_table,
              mlstm_conv_w, mlstm_conv_b, mlstm_gate_b, mlstm_out_gain,
              w_branch_attn, w_branch_mlstm, merge_b, w_out, norm2_g,
              w_router_group, b_router_group, w_router_expert, b_router_expert,
              w_expert_gate, w_expert_up, w_expert_down):
    for l in range(DEPTH):
        h = rmsnorm(x, norm1_g[l])
        proj = h @ w_in[l]
        qa, ka, va, qm, km, vm, om, gm, mg = split_cols(proj, IN_SPLITS)
        ya = windowed_gqa(qa, ka, va, attn_q_gain[l], attn_k_gain[l], rel_bias_table, attn_sink[l])
        ym = mlstm_branch(qm, km, vm, om, gm, mlstm_conv_w[l], mlstm_conv_b[l],
                          mlstm_gate_b[l], mlstm_out_gain[l])
        gates = jax.nn.sigmoid(mg + merge_b[l])
        u = gates[..., :D_MODEL] * (ya @ w_branch_attn[l]) + gates[..., D_MODEL:] * (ym @ w_branch_mlstm[l])
        x = x + u @ w_out[l]
        x = x + hier_moe(rmsnorm(x, norm2_g[l]), w_router_group[l], b_router_group[l],
                         w_router_expert[l], b_router_expert[l],
                         w_expert_gate[l], w_expert_up[l], w_expert_down[l])
    return x
```

```cpp
#include <hip/hip_runtime.h>
#include <stdio.h>
#include <math.h>
#define MK_LAUNCHES {0,11,0}
#define MK_NPH 11

namespace mk {
#define LAS __attribute__((address_space(3)))
#define GAS __attribute__((address_space(1)))
typedef unsigned short bf16;
typedef short bf16x8 __attribute__((ext_vector_type(8)));
typedef short s16x4 __attribute__((ext_vector_type(4)));
typedef float f32x4 __attribute__((ext_vector_type(4)));
typedef float f32x2 __attribute__((ext_vector_type(2)));
typedef float f32x16 __attribute__((ext_vector_type(16)));
typedef unsigned u32x4 __attribute__((ext_vector_type(4)));
typedef unsigned u32x2 __attribute__((ext_vector_type(2)));
typedef GAS unsigned gu32;

constexpr int Bz = 8, S = 2048, D = 1024, T = Bz * S;
constexpr int NPAD = 5120;
constexpr int PA_LD = 2816;
constexpr int PC_QA = 0, PC_KA = 512, PC_VA = 640, PC_QM = 768, PC_KM = 1280, PC_VM = 1792, PC_OM = 2304;
constexpr int NE = 32, DE = 512;
constexpr int NWAVES = 8;

constexpr size_t MiB = (size_t)1 << 20;
constexpr size_t WS_CTL = 0, CTL_ZERO_BYTES = 1 * MiB;
constexpr size_t WS_WIN_T = 1 * MiB;
constexpr size_t WS_WA_T = 11 * MiB;
constexpr size_t WS_WM_T = 12 * MiB;
constexpr size_t WS_WOUT_T = 13 * MiB;
constexpr size_t WS_GM = 15 * MiB;
constexpr size_t WS_TOK = 16 * MiB;
constexpr size_t WS_EXP = 20 * MiB;
constexpr size_t EXP_STRIDE = 3 * MiB, EXP_DN_OFF = 2 * MiB;
constexpr size_t WS_D = 116 * MiB;
constexpr size_t WS_E = 148 * MiB;
constexpr size_t WS_YA = 246 * MiB; constexpr size_t WS_END = 262 * MiB;
constexpr int CW_TMO = 0, CW_CODE = 1;
constexpr int CW_CNT = 64;
constexpr int CW_BAR = 4096;
constexpr int CW_PAN = 32768;
constexpr int CW_CONV = 45056;
constexpr int CW_PANU = 36864, CW_PANT = 40960;
constexpr int CW_TILE = 65536;
constexpr int RING_BYTES = 131072;
constexpr int LDS_BYTES = 163840;
constexpr int LDSCTL_OFF = LDS_BYTES - 4096, MISC_OFF = LDSCTL_OFF;
constexpr int MOE_TAB_OFF = LDSCTL_OFF + 256;

#define LDS_WAIT() asm volatile("s_waitcnt lgkmcnt(0)" ::: "memory")
#define VM_WAIT() asm volatile("s_waitcnt vmcnt(0)" ::: "memory")
__device__ __forceinline__ unsigned f2bf(float f) { unsigned u = __builtin_bit_cast(unsigned, f); return (u + 0x7fffu + ((u >> 16) & 1u)) >> 16; }

__device__ __forceinline__ float bf_lo(unsigned w) { return __builtin_bit_cast(float, w << 16); }
__device__ __forceinline__ float bf_hi(unsigned w) { return __builtin_bit_cast(float, w & 0xffff0000u); }
typedef __bf16 bf16x2_t __attribute__((ext_vector_type(2)));
__device__ __forceinline__ unsigned cvt_pk_bf16(float lo, float hi) { f32x2 v = {lo, hi}; bf16x2_t b = __builtin_convertvector(v, bf16x2_t); return __builtin_bit_cast(unsigned, b); }
__device__ __forceinline__ unsigned pk2(float lo, float hi) { return cvt_pk_bf16(lo, hi); }
__device__ __forceinline__ float sigm(float x) { return __builtin_amdgcn_rcpf(1.f + __builtin_amdgcn_exp2f(-1.4426950408889634f * x)); }
#define DPP_ADD(v, ctrl, rm) ((v) + __builtin_bit_cast(float, __builtin_amdgcn_update_dpp(0, __builtin_bit_cast(int, (v)), (ctrl), (rm), 0xF, true)))
__device__ __forceinline__ float wave_sum(float v) {
    v = DPP_ADD(v, 0xB1, 0xF);
    v = DPP_ADD(v, 0x4E, 0xF);
    v = DPP_ADD(v, 0x141, 0xF);
    v = DPP_ADD(v, 0x140, 0xF);
    v = DPP_ADD(v, 0x142, 0xA);
    v = DPP_ADD(v, 0x143, 0xC);
    return __builtin_bit_cast(float, __builtin_amdgcn_readlane(__builtin_bit_cast(int, v), 63));
}

#define XB_TMO      128
#define XB_XCNT(j)  (256  + 64 * (j))
#define XB_XSUB(j)  (1280 + 64 * (j))
#define XB_XGEN(j)  (2304 + 64 * (j))
#define XB_TOP      3328
#define XB_TOPGEN   3392
#define XCD_BAR_WORDS 3456
#define XB_SPIN_CAP (1u << 18)
__device__ __forceinline__ unsigned xb_ld(unsigned* p)              { return __hip_atomic_load(p, __ATOMIC_RELAXED, __HIP_MEMORY_SCOPE_AGENT); }
__device__ __forceinline__ unsigned xb_add(unsigned* p, unsigned v) { return __hip_atomic_fetch_add(p, v, __ATOMIC_RELAXED, __HIP_MEMORY_SCOPE_AGENT); }
__device__ __forceinline__ unsigned xb_xcc_id() { return (unsigned)__builtin_amdgcn_s_getreg((3 << 11) | 20) & 0xFu; }
#define XB_SPIN(cond, bar) do { unsigned _sp = 0; while (cond) { __builtin_amdgcn_s_sleep(1); \
    if ((++_sp & 255u) == 0u) { if (xb_ld(&(bar)[XB_TMO])) break; if (_sp > XB_SPIN_CAP) { atomicAdd(&(bar)[XB_TMO], 1u); break; } } } } while (0)
struct XcdBarrier { unsigned* bar; unsigned x; volatile LAS unsigned* st; };
__device__ __forceinline__ XcdBarrier xcd_barrier_post(unsigned* bar, volatile LAS unsigned* st) {
    XcdBarrier b; b.bar = bar; b.x = xb_xcc_id(); b.st = st;
    if (threadIdx.x == 0) (void)xb_add(&bar[XB_XCNT(b.x)], 1u);
    return b;
}
__device__ __forceinline__ void xcd_barrier_complete(unsigned* bar, unsigned x, unsigned& nloc, unsigned& nx) {
    const unsigned G = gridDim.x * gridDim.y * gridDim.z;
    unsigned sum, cnt, mine, sp = 0u;
    for (;;) {
        sum = 0u; cnt = 0u; mine = 0u;
#pragma unroll
        for (unsigned j = 0; j < 16; ++j) { const unsigned c = xb_ld(&bar[XB_XCNT(j)]); sum += c; cnt += (c > 0u) ? 1u : 0u; mine = (j == x) ? c : mine; }
        if (sum == G) break;
        __builtin_amdgcn_s_sleep(1);
        if ((++sp & 255u) == 0u) { if (xb_ld(&bar[XB_TMO])) break; if (sp > XB_SPIN_CAP) { atomicAdd(&bar[XB_TMO], 1u); break; } }
    }
    nloc = mine > 0u ? mine : 1u; nx = cnt > 0u ? cnt : 1u;
}
__device__ __forceinline__ void xcd_barrier(const XcdBarrier& b) {
    asm volatile("s_waitcnt vmcnt(0)" ::: "memory");
    __syncthreads();
    if (threadIdx.x == 0) {
        unsigned* bar = b.bar;
        __builtin_amdgcn_s_waitcnt(0);
        unsigned nloc = b.st[0], nx = b.st[1];
        if (nloc == 0u) { xcd_barrier_complete(bar, b.x, nloc, nx); b.st[0] = nloc; b.st[1] = nx; }
        const unsigned old = xb_add(&bar[XB_XSUB(b.x)], 1u);
        const unsigned gen = old / nloc;
        if (old + 1u == (gen + 1u) * nloc) {
            __builtin_amdgcn_fence(__ATOMIC_RELEASE, "agent");
            asm volatile("s_waitcnt vmcnt(0)" ::: "memory");
            const unsigned og = xb_add(&bar[XB_TOP], 1u);
            const unsigned tg = og / nx;
            if (og + 1u == (tg + 1u) * nx) xb_add(&bar[XB_TOPGEN], 1u);
            else XB_SPIN(xb_ld(&bar[XB_TOPGEN]) == tg, bar);
            __builtin_amdgcn_fence(__ATOMIC_ACQUIRE, "agent");
            xb_add(&bar[XB_XGEN(b.x)], 1u);
            asm volatile("s_waitcnt vmcnt(0)" ::: "memory");
        } else {
            XB_SPIN(xb_ld(&bar[XB_XGEN(b.x)]) == gen, bar);
            __builtin_amdgcn_fence(__ATOMIC_ACQUIRE, "agent");
            asm volatile("s_waitcnt vmcnt(0)" ::: "memory");
        }
    }
    __syncthreads();
}


__device__ __forceinline__ void panel_wait(unsigned* cnt, unsigned need, unsigned* tmo) {
    if (threadIdx.x < 64) {
        unsigned polls = 0;
        while ((unsigned)__builtin_amdgcn_readfirstlane(__hip_atomic_load(cnt, __ATOMIC_RELAXED, __HIP_MEMORY_SCOPE_AGENT)) < need) {
            __builtin_amdgcn_s_sleep(2);
            if ((++polls & 1023u) == 0u) { if (__builtin_amdgcn_readfirstlane(__hip_atomic_load(tmo, __ATOMIC_RELAXED, __HIP_MEMORY_SCOPE_AGENT)) != 0u) break;
                if (polls > (1u << 22)) { if (threadIdx.x == 0) __hip_atomic_store(tmo, 1u, __ATOMIC_RELAXED, __HIP_MEMORY_SCOPE_AGENT); break; } }
        }
        __builtin_amdgcn_fence(__ATOMIC_ACQUIRE, "agent");
        asm volatile("s_waitcnt vmcnt(0)" ::: "memory");
    }
    asm volatile("" ::: "memory"); __builtin_amdgcn_s_barrier(); asm volatile("" ::: "memory");
}

constexpr int BM = 256, BK = 64, HALF = 128, HTB = HALF * BK * 2, STAGE_BYTES = 8 * HTB, NXCD = 8, WGM = 8;
__host__ __device__ __forceinline__ int lds_byte(int r, int c) { const int st = (r >> 4) * 2 + (c >> 5), rr = r & 15, cc = c & 31, ob = rr * 64 + cc * 2; return st * 1024 + (ob ^ (((ob >> 9) & 1) << 5)); }
__host__ __device__ __forceinline__ void stage_rc(int b, int& R, int& C) { const int st = b / 1024, sb = b % 1024, swz = sb ^ (((sb >> 9) & 1) << 5); R = (st >> 1) * 16 + swz / 64; C = (st & 1) * 32 + (swz % 64) / 2; }
__host__ __device__ __forceinline__ int perm32(int rho) { const int n = rho >> 4, i = rho & 15; return 8 * (i >> 2) + 4 * n + (i & 3); }

struct Unit { int pm, pn, aux; const char* A; const char* B; };
__device__ __forceinline__ bool tile_order(int i, int G, int c, int nM, int nN, int& pm, int& pn) {
    const int nwg = nM * nN; const long L = (long)i * G + c; if (L >= nwg) return false;
    int wgid = (int)L; { const int q = nwg / NXCD, r = nwg % NXCD, xcd = wgid % NXCD, off = wgid / NXCD; wgid = (xcd < r ? xcd * (q + 1) : r * (q + 1) + (xcd - r) * q) + off; }
    const int nig = WGM * nN, gid = wgid / nig, fm = gid * WGM, gsz = (nM - fm) < WGM ? (nM - fm) : WGM;
    pm = fm + ((wgid % nig) % gsz); pn = (wgid % nig) / gsz; return true;
}

template <class Epi, class Sched>
__device__ __forceinline__ void gemm_phase(LAS unsigned char* lds, const int K, const Sched& S, const Epi& E) {
    const int tid = threadIdx.x, wid = __builtin_amdgcn_readfirstlane(tid >> 6), lane = tid & 63, wr = wid >> 2, wc = wid & 3, fr = lane & 15, fq = lane >> 4;
    const int nt = K / BK;
    unsigned voffB[2];
#pragma unroll
    for (int i = 0; i < 2; ++i) { int R, C; stage_rc(tid * 16 + i * 8192, R, C); const int Rb = Epi::PERM ? ((R & ~31) + perm32(R & 31)) : R; voffB[i] = (unsigned)(Rb * K + C) * 2u; }
    const size_t kstep = (size_t)(BK * 2);
    const size_t hstepB = (size_t)HALF * K * 2;
    const unsigned ldsw = (unsigned)wid * 1024u;
    const int aoff = lds_byte(wr * 64 + fr, fq * 8), boff = lds_byte(wc * 32 + fr, fq * 8);
#define PG8_SA(b, h) (((b) * 2 + (h)) * HTB)
#define PG8_SB(b, h) ((4 + (b) * 2 + (h)) * HTB)
#define PG8_STAGE(bufoff, gbase, voff) do { _Pragma("unroll") for (int _i = 0; _i < 2; ++_i) \
        __builtin_amdgcn_global_load_lds((const unsigned*)((const char*)(gbase) + (voff)[_i]), (LAS unsigned*)(lds + (bufoff) + ldsw + _i * 8192), 16, 0, 0); } while (0)
#define PG8_LDA(dst, b, h) do { _Pragma("unroll") for (int m = 0; m < 4; ++m) _Pragma("unroll") for (int k = 0; k < 2; ++k) dst[m][k] = *(const LAS bf16x8*)(lds + PG8_SA(b, h) + aoff + m * 2048 + k * 1024); } while (0)
#define PG8_LDB(dst, b, h) do { _Pragma("unroll") for (int n = 0; n < 2; ++n) _Pragma("unroll") for (int k = 0; k < 2; ++k) dst[n][k] = *(const LAS bf16x8*)(lds + PG8_SB(b, h) + boff + n * 2048 + k * 1024); } while (0)
#define PG8_MMA(ai, bj, At, Bt) do { __builtin_amdgcn_s_setprio(1); _Pragma("unroll") for (int m = 0; m < 4; ++m) _Pragma("unroll") for (int n = 0; n < 2; ++n) _Pragma("unroll") for (int k = 0; k < 2; ++k) \
        acc[ai][bj][m][n] = __builtin_amdgcn_mfma_f32_16x16x32_bf16(Bt[n][k], At[m][k], acc[ai][bj][m][n], 0, 0, 0); __builtin_amdgcn_s_setprio(0); } while (0)
#define PG8_WAIT_V(n) asm volatile("s_waitcnt vmcnt(" #n ")" ::: "memory")
#define PG8_WAIT_L(n) asm volatile("s_waitcnt lgkmcnt(" #n ")" ::: "memory")
#define PG8_BAR __builtin_amdgcn_s_barrier()
#define PG8_SCHED __builtin_amdgcn_sched_barrier(0)
    Unit cur, nxt; int ui = 0;
    if (!S.next(0, cur)) return;
    f32x4 acc[2][2][4][2];
#pragma unroll
    for (int a = 0; a < 2; ++a)
#pragma unroll
        for (int b = 0; b < 2; ++b)
#pragma unroll
            for (int m = 0; m < 4; ++m)
#pragma unroll
                for (int n = 0; n < 2; ++n) acc[a][b][m][n] = (f32x4){0.f, 0.f, 0.f, 0.f};
    bf16x8 At[4][2], B0[2][2], B1[2][2];
    unsigned voC[2][2], voN[2][2];
    S.a_ready(cur);
    S.lane_offs(cur, tid, voC);
    const char* cA = cur.A; const char* cB = cur.B;
    PG8_STAGE(PG8_SB(0, 0), cB, voffB); PG8_STAGE(PG8_SB(0, 1), cB + hstepB, voffB); PG8_STAGE(PG8_SA(0, 0), cA, voC[0]); PG8_STAGE(PG8_SA(0, 1), cA, voC[1]);
    if (wr == 1) PG8_BAR;
    PG8_WAIT_V(2); PG8_BAR;
    PG8_STAGE(PG8_SB(1, 0), cB + kstep, voffB); PG8_STAGE(PG8_SA(1, 0), cA + kstep, voC[0]); PG8_STAGE(PG8_SB(1, 1), cB + hstepB + kstep, voffB);
    PG8_WAIT_V(6); PG8_BAR;
    for (;;) {
        const bool has_next = S.next(ui + 1, nxt);
        const char* nA = has_next ? nxt.A : cA; const char* nB = has_next ? nxt.B : cB;
        if (has_next) S.lane_offs(nxt, tid, voN);
        else { voN[0][0] = voC[0][0]; voN[0][1] = voC[0][1]; voN[1][0] = voC[1][0]; voN[1][1] = voC[1][1]; }
        for (int t = 0; t < nt; t += 2) {
            const bool last = (t == nt - 2);
            if (last && has_next) S.a_ready(nxt);
            const char* a1 = cA + (size_t)(t + 1) * kstep;
            const char* a2 = last ? nA : cA + (size_t)(t + 2) * kstep; const char* b2 = last ? nB : cB + (size_t)(t + 2) * kstep;
            const char* a3 = a2 + kstep; const char* b3 = b2 + kstep;
            unsigned v20[2], v21[2];
            v20[0] = last ? voN[0][0] : voC[0][0]; v20[1] = last ? voN[0][1] : voC[0][1]; v21[0] = last ? voN[1][0] : voC[1][0]; v21[1] = last ? voN[1][1] : voC[1][1];
            PG8_LDB(B0, 0, 0); PG8_LDB(B1, 0, 1); PG8_SCHED; PG8_LDA(At, 0, 0); PG8_STAGE(PG8_SA(1, 1), a1, voC[1]);
            PG8_WAIT_V(8); PG8_WAIT_L(0); PG8_BAR; PG8_MMA(0, 0, At, B0); PG8_MMA(0, 1, At, B1); PG8_BAR; PG8_SCHED;
            PG8_LDA(At, 0, 1); PG8_STAGE(PG8_SB(0, 0), b2, voffB); PG8_STAGE(PG8_SB(0, 1), b2 + hstepB, voffB); PG8_STAGE(PG8_SA(0, 0), a2, v20);
            PG8_WAIT_V(8); PG8_WAIT_L(0); PG8_BAR; PG8_MMA(1, 0, At, B0); PG8_MMA(1, 1, At, B1); PG8_BAR; PG8_SCHED;
            PG8_LDB(B0, 1, 0); PG8_LDB(B1, 1, 1); PG8_SCHED; PG8_LDA(At, 1, 0); PG8_STAGE(PG8_SA(0, 1), a2, v21);
            PG8_WAIT_V(8); PG8_WAIT_L(0); PG8_BAR; PG8_MMA(0, 0, At, B0); PG8_MMA(0, 1, At, B1); PG8_BAR; PG8_SCHED;
            PG8_LDA(At, 1, 1); PG8_STAGE(PG8_SB(1, 0), b3, voffB); PG8_STAGE(PG8_SB(1, 1), b3 + hstepB, voffB); PG8_STAGE(PG8_SA(1, 0), a3, v20);
            PG8_WAIT_V(8); PG8_WAIT_L(0); PG8_BAR; PG8_MMA(1, 0, At, B0); PG8_MMA(1, 1, At, B1); PG8_BAR; PG8_SCHED;
        }
        if (wr == 0) PG8_BAR;
        E(acc, cur, wr, wc, fr, fq);
        if (!has_next) break;
#pragma unroll
        for (int a = 0; a < 2; ++a)
#pragma unroll
            for (int b = 0; b < 2; ++b)
#pragma unroll
                for (int m = 0; m < 4; ++m)
#pragma unroll
                    for (int n = 0; n < 2; ++n) acc[a][b][m][n] = (f32x4){0.f, 0.f, 0.f, 0.f};
        cur = nxt; cA = nA; cB = nB; ++ui;
        voC[0][0] = voN[0][0]; voC[0][1] = voN[0][1]; voC[1][0] = voN[1][0]; voC[1][1] = voN[1][1];
        if (wr == 1) PG8_BAR;
    }
    PG8_WAIT_V(0);
    PG8_BAR;
#undef PG8_SA
#undef PG8_SB
#undef PG8_STAGE
#undef PG8_LDA
#undef PG8_LDB
#undef PG8_MMA
#undef PG8_WAIT_V
#undef PG8_WAIT_L
#undef PG8_BAR
#undef PG8_SCHED
}

struct Args { const float* in[23]; float* out; unsigned char* ws; int ph_lo, ph_hi, li, dry; };
struct Frame {
    LAS unsigned char* lds; volatile LAS unsigned* MISC; gu32* ctl;
    int tid, lane, wave, vcu, G;
};

constexpr int TP_PITCH = 136;
template <class SCol, class DRow>
__device__ __forceinline__ void p0_transpose_item(const float* W, int K, int N, int nblk, bf16* WT, LAS unsigned char* scr, int item, int lane, SCol scol, DRow drow) {
    const int kb = item / nblk, nb = item - kb * nblk, k0 = 64 * kb, n0 = 64 * nb;
    const int kr = lane >> 4, n4 = lane & 15;
    const int sc = scol(n0 + 4 * n4);
    f32x4 v[8][2];
#pragma unroll
    for (int i = 0; i < 8; ++i)
#pragma unroll
        for (int pp = 0; pp < 2; ++pp) v[i][pp] = (sc >= 0) ? *(const GAS f32x4*)(W + (size_t)(k0 + 8 * i + 2 * kr + pp) * N + sc) : (f32x4){0.f, 0.f, 0.f, 0.f};
#pragma unroll
    for (int i = 0; i < 8; ++i)
#pragma unroll
        for (int j = 0; j < 4; ++j) *(LAS unsigned*)(scr + (4 * n4 + j) * TP_PITCH + (4 * i + kr) * 4) = cvt_pk_bf16(v[i][0][j], v[i][1][j]);
    LDS_WAIT(); asm volatile("" ::: "memory");
#pragma unroll
    for (int i = 0; i < 8; ++i) { const int nr = 8 * i + (lane >> 3), pc = lane & 7;
        const u32x2 a = *(const LAS u32x2*)(scr + nr * TP_PITCH + pc * 16), b = *(const LAS u32x2*)(scr + nr * TP_PITCH + pc * 16 + 8);
        *(GAS u32x4*)(WT + (size_t)drow(n0 + nr) * K + k0 + 8 * pc) = (u32x4){a.x, a.y, b.x, b.y}; }
    LDS_WAIT(); asm volatile("" ::: "memory");
}
__device__ __forceinline__ int win_src_col(int n) { return n < 2816 ? n : (n < 4864 ? n + 16 : (n < 4880 ? n - 2048 : -1)); }

__device__ __forceinline__ void p0_prologue(Frame& F, const Args& a) {
    LAS unsigned char* scr = F.lds + F.wave * 16384;
    const int gw = F.vcu * NWAVES + F.wave, NGW = F.G * NWAVES;
    unsigned char* ws = a.ws;
    const float* w_in = a.in[2];
    constexpr int I_IN = (D / 64) * (NPAD / 64);
    for (int it = gw; it < I_IN; it += NGW)
        p0_transpose_item(w_in, D, 4880, NPAD / 64, (bf16*)(ws + WS_WIN_T), scr, it, F.lane, [](int n) { return win_src_col(n); }, [](int n) { return n; });
    const float* x = a.in[0]; const float* g1 = a.in[1]; bf16* XN = (bf16*)(ws + WS_D);
    f32x4 gv[4];
#pragma unroll
    for (int j = 0; j < 4; ++j) gv[j] = ((const GAS f32x4*)g1)[F.lane + 64 * j];
    for (int m = gw; m < T; m += NGW) {
        const GAS f32x4* xr = (const GAS f32x4*)(x + (size_t)m * D) + F.lane;
        f32x4 v[4]; float s = 0.f;
#pragma unroll
        for (int j = 0; j < 4; ++j) { v[j] = xr[64 * j]; s += (v[j].x * v[j].x + v[j].y * v[j].y) + (v[j].z * v[j].z + v[j].w * v[j].w); }
        const float rstd = rsqrtf(wave_sum(s) * (1.f / D) + 1e-6f);
        GAS unsigned long long* o8 = (GAS unsigned long long*)(XN + (size_t)m * D) + F.lane;
#pragma unroll
        for (int j = 0; j < 4; ++j) { const f32x4 y = v[j] * rstd * gv[j]; o8[64 * j] = (unsigned long long)pk2(y.x, y.y) | ((unsigned long long)pk2(y.z, y.w) << 32); }
    }
}

__device__ __forceinline__ void p0_experts(Frame& F, const Args& a, int item_lo, int item_hi, int rank, int nranks) {
    LAS unsigned char* scr = F.lds + F.wave * 16384;
    unsigned char* ws = a.ws;
    const float* w_g = a.in[20]; const float* w_u = a.in[21]; const float* w_d = a.in[22];
    constexpr int I_G = (D / 64) * (DE / 64), I_D = (DE / 64) * (D / 64), I_EXP = 2 * I_G + I_D;
    constexpr int I_A = (512 / 64) * (D / 64), I_OUT = (D / 64) * (D / 64);
    for (int it = item_lo + rank * NWAVES + F.wave; it < item_hi; it += nranks * NWAVES) {
        if (it >= NE * I_EXP) {
            int r2 = it - NE * I_EXP;
            if (r2 < I_A) { p0_transpose_item(a.in[11], 512, D, D / 64, (bf16*)(ws + WS_WA_T), scr, r2, F.lane, [](int n) { return n; }, [](int n) { return n; }); continue; } r2 -= I_A;
            if (r2 < I_A) { p0_transpose_item(a.in[12], 512, D, D / 64, (bf16*)(ws + WS_WM_T), scr, r2, F.lane, [](int n) { return n; }, [](int n) { return n; }); continue; } r2 -= I_A;
            p0_transpose_item(a.in[14], D, D, D / 64, (bf16*)(ws + WS_WOUT_T), scr, r2, F.lane, [](int n) { return n; }, [](int n) { return n; }); continue;
        }
        const int e = it / I_EXP; int r = it - e * I_EXP;
        bf16* gu = (bf16*)(ws + WS_EXP + (size_t)e * EXP_STRIDE); bf16* dn = (bf16*)(ws + WS_EXP + (size_t)e * EXP_STRIDE + EXP_DN_OFF);
        if (r < I_G) { p0_transpose_item(w_g + (size_t)e * D * DE, D, DE, DE / 64, gu, scr, r, F.lane, [](int n) { return n; }, [](int n) { return 256 * (n >> 7) + (n & 127); }); continue; } r -= I_G;
        if (r < I_G) { p0_transpose_item(w_u + (size_t)e * D * DE, D, DE, DE / 64, gu, scr, r, F.lane, [](int n) { return n; }, [](int n) { return 256 * (n >> 7) + 128 + (n & 127); }); continue; } r -= I_G;
        p0_transpose_item(w_d + (size_t)e * DE * D, DE, D, D / 64, dn, scr, r, F.lane, [](int n) { return n; }, [](int n) { return n; });
    }
    LDS_WAIT();
    __syncthreads();
}

constexpr int EXP_ITEMS = NE * (2 * (D / 64) * (DE / 64) + (DE / 64) * (D / 64)) + 2 * (512 / 64) * (D / 64) + (D / 64) * (D / 64);
#ifndef MK_EXP_SPLIT_A
#define MK_EXP_SPLIT_A 3072
#define MK_EXP_SPLIT_B 6144
#define MK_EXP_SPLIT_C 9216
#define MK_EXP_SPLIT_D 12288
#endif
struct SchedP1 {
    int G, c; const char* A; const char* B;
    __device__ __forceinline__ void a_ready(const Unit&) const {}
    __device__ __forceinline__ bool next(int i, Unit& u) const { if (!tile_order(i, G, c, T / BM, NPAD / BM, u.pm, u.pn)) return false; u.aux = 0; u.A = A + (size_t)u.pm * BM * D * 2; u.B = B + (size_t)u.pn * BM * D * 2; return true; }
    __device__ __forceinline__ void lane_offs(const Unit&, int tid, unsigned (&vo)[2][2]) const {
#pragma unroll
        for (int i = 0; i < 2; ++i) { int R, C; stage_rc(tid * 16 + i * 8192, R, C); vo[0][i] = (unsigned)(R * D + C) * 2u; vo[1][i] = (unsigned)((R + HALF) * D + C) * 2u; }
    }
};
struct EpiP1 {
    static constexpr bool PERM = true;
    bf16* PA; bf16* MG; float* GM; const float* merge_b; const float* gate_b;
    __device__ __forceinline__ void operator()(const f32x4 (&acc)[2][2][4][2], const Unit& u, int wr, int wc, int fr, int fq) const {
        const int row0 = u.pm * BM + wr * 64 + fr;
        if (u.pn < 11) {
            const int col0 = u.pn * BM + wc * 32 + 8 * fq;
#pragma unroll
            for (int ai = 0; ai < 2; ++ai)
#pragma unroll
                for (int m = 0; m < 4; ++m) { bf16* rowp = PA + (size_t)(row0 + ai * HALF + m * 16) * PA_LD + col0;
#pragma unroll
                    for (int bj = 0; bj < 2; ++bj) { const f32x4 v0 = acc[ai][bj][m][0], v1 = acc[ai][bj][m][1];
                        u32x4 w; w.x = cvt_pk_bf16(v0[0], v0[1]); w.y = cvt_pk_bf16(v0[2], v0[3]); w.z = cvt_pk_bf16(v1[0], v1[1]); w.w = cvt_pk_bf16(v1[2], v1[3]);
                        *(u32x4*)(rowp + bj * HALF) = w; } }
        } else if (u.pn < 19) {
            const int col0 = (u.pn - 11) * BM + wc * 32 + 8 * fq;
            f32x4 bv[2][2];
#pragma unroll
            for (int bj = 0; bj < 2; ++bj)
#pragma unroll
                for (int n = 0; n < 2; ++n) bv[bj][n] = *(const f32x4*)(merge_b + col0 + bj * HALF + 4 * n);
#pragma unroll
            for (int ai = 0; ai < 2; ++ai)
#pragma unroll
                for (int m = 0; m < 4; ++m) { bf16* rowp = MG + (size_t)(row0 + ai * HALF + m * 16) * 2048 + col0;
#pragma unroll
                    for (int bj = 0; bj < 2; ++bj) { f32x4 v0 = acc[ai][bj][m][0] + bv[bj][0], v1 = acc[ai][bj][m][1] + bv[bj][1];
#pragma unroll
                        for (int j = 0; j < 4; ++j) { v0[j] = sigm(v0[j]); v1[j] = sigm(v1[j]); }
                        u32x4 w; w.x = cvt_pk_bf16(v0[0], v0[1]); w.y = cvt_pk_bf16(v0[2], v0[3]); w.z = cvt_pk_bf16(v1[0], v1[1]); w.w = cvt_pk_bf16(v1[2], v1[3]);
                        *(u32x4*)(rowp + bj * HALF) = w; } }
        } else {
            if (wc == 0 && fq < 2) {
                const f32x4 b0 = *(const f32x4*)(gate_b + 8 * fq), b1 = *(const f32x4*)(gate_b + 8 * fq + 4);
#pragma unroll
                for (int ai = 0; ai < 2; ++ai)
#pragma unroll
                    for (int m = 0; m < 4; ++m) { float* rowp = GM + (size_t)(row0 + ai * HALF + m * 16) * 16 + 8 * fq;
                        *(f32x4*)(rowp) = acc[ai][0][m][0] + b0; *(f32x4*)(rowp + 4) = acc[ai][0][m][1] + b1; }
            }
        }
    }
};

constexpr int AT_K_OFF = 0;
constexpr int AT_VT_OFF = 49152, AT_VT_LD = 396;
constexpr int AT_TAB_OFF = AT_VT_OFF + 64 * AT_VT_LD * 2;
constexpr int AT_TAB_LD = 328;
constexpr int AT_BKT_OFF = AT_TAB_OFF + 4 * AT_TAB_LD * 4;
constexpr int AT_LDS_END = AT_BKT_OFF + 4 * 32 * 4;
static_assert(AT_LDS_END <= RING_BYTES, "attention LDS");
constexpr float LOG2E = 1.4426950408889634f;

__device__ __forceinline__ int t5_bucket(int rel) {
    const int sign = rel > 0 ? 16 : 0; const int n = rel < 0 ? -rel : rel;
    if (n < 8) return sign + n;
    int k = 0; while (64 * (2 << k) <= n * n) ++k;
    int large = 8 + k; if (large > 15) large = 15;
    return sign + large;
}
__device__ __forceinline__ int crow(int r, int hi) { return (r & 3) + 8 * (r >> 2) + 4 * hi; }
__device__ __forceinline__ float x32_max(float v) { const auto rr = __builtin_amdgcn_permlane32_swap(__float_as_uint(v), __float_as_uint(v), false, false); return fmaxf(__uint_as_float(rr[0]), __uint_as_float(rr[1])); }
__device__ __forceinline__ float x32_sum(float v) { const auto rr = __builtin_amdgcn_permlane32_swap(__float_as_uint(v), __float_as_uint(v), false, false); return __uint_as_float(rr[0]) + __uint_as_float(rr[1]); }

__device__ __forceinline__ void conv_issue(Frame& F, const Args& a, int cu, u32x4 (&win)[12]) {
    const bf16* PA = (const bf16*)(a.ws + WS_E);
    int tz = F.tid; asm volatile("" : "+v"(tz));
    const int c8 = tz & 127, rg = tz >> 7;
    const int t0 = cu * 32 + rg * 8, s0 = t0 & (S - 1);
#pragma unroll
    for (int i = 0; i < 12; ++i) { const int sp = s0 + i - 2; const bool ok = sp >= 0 && sp < S;
        win[i] = *(const GAS u32x4*)(PA + (size_t)(ok ? t0 + i - 2 : t0) * PA_LD + PC_QM + 8 * c8); if (!ok) win[i] = (u32x4){0u, 0u, 0u, 0u}; }
}
__device__ __forceinline__ void conv_finish(Frame& F, const Args& a, int cu, const u32x4 (&win)[12]) {
    bf16* QK = (bf16*)(a.ws + WS_D);
    const float* cw = a.in[7]; const float* cb = a.in[8];
    int tz = F.tid; asm volatile("" : "+v"(tz));
    const int c8 = tz & 127, rg = tz >> 7;
    const int t0 = cu * 32 + rg * 8;
    float w[5][8], bias[8];
#pragma unroll
    for (int j = 0; j < 5; ++j) { const f32x4 x0 = *(const GAS f32x4*)(cw + j * 1024 + 8 * c8), x1 = *(const GAS f32x4*)(cw + j * 1024 + 8 * c8 + 4);
        w[j][0] = x0.x; w[j][1] = x0.y; w[j][2] = x0.z; w[j][3] = x0.w; w[j][4] = x1.x; w[j][5] = x1.y; w[j][6] = x1.z; w[j][7] = x1.w; }
    { const f32x4 x0 = *(const GAS f32x4*)(cb + 8 * c8), x1 = *(const GAS f32x4*)(cb + 8 * c8 + 4);
        bias[0] = x0.x; bias[1] = x0.y; bias[2] = x0.z; bias[3] = x0.w; bias[4] = x1.x; bias[5] = x1.y; bias[6] = x1.z; bias[7] = x1.w; }
#pragma unroll
    for (int r = 0; r < 8; ++r) {
        float acc[8];
#pragma unroll
        for (int e = 0; e < 8; ++e) acc[e] = bias[e];
#pragma unroll
        for (int j = 0; j < 5; ++j) { const u32x4 x = win[r + j];
            acc[0] += w[j][0] * bf_lo(x.x); acc[1] += w[j][1] * bf_hi(x.x); acc[2] += w[j][2] * bf_lo(x.y); acc[3] += w[j][3] * bf_hi(x.y);
            acc[4] += w[j][4] * bf_lo(x.z); acc[5] += w[j][5] * bf_hi(x.z); acc[6] += w[j][6] * bf_lo(x.w); acc[7] += w[j][7] * bf_hi(x.w); }
#pragma unroll
        for (int e = 0; e < 8; ++e) acc[e] = acc[e] * sigm(acc[e]);
        u32x4 o; o.x = cvt_pk_bf16(acc[0], acc[1]); o.y = cvt_pk_bf16(acc[2], acc[3]); o.z = cvt_pk_bf16(acc[4], acc[5]); o.w = cvt_pk_bf16(acc[6], acc[7]);
        *(GAS u32x4*)(QK + (size_t)(t0 + r) * 1024 + 8 * c8) = o;
    }
}
__device__ __forceinline__ void attn_unit(Frame& F, const Args& a, int b, int nb, int kv, int cu0, int cu1) {
    LAS unsigned char* lds = F.lds;
    const bf16* PA = (const bf16*)(a.ws + WS_E);
    bf16* YA = (bf16*)(a.ws + WS_YA);
    const float* qg = a.in[3]; const float* kg = a.in[4]; const float* sink = a.in[5]; const float* relt = a.in[6];
    int tid_ = F.tid; asm volatile("" : "+v"(tid_));
    const int tid = tid_, lane = tid & 63, wid = F.wave;
    const size_t row_band0 = (size_t)b * S + (size_t)(nb - 1) * 128;
    const int g = wid >> 1, h = kv * 4 + g, r32 = lane & 31, hi = lane >> 5;
    {
        const int c = tid & 7;
        f32x4 g0 = *(const GAS f32x4*)(kg + 8 * c), g1 = *(const GAS f32x4*)(kg + 8 * c + 4);
        u32x4 krs[6], vrs[6];
#pragma unroll
        for (int it = 0; it < 6; ++it) {
            const int kpos = (nb - 1) * 128 + (tid >> 3) + 64 * it; const bool ok = kpos >= 0 && kpos < S;
            const bf16* rp = PA + ((size_t)b * S + (size_t)(ok ? kpos : 0)) * PA_LD;
            krs[it] = *(const GAS u32x4*)(rp + PC_KA + kv * 64 + 8 * c); vrs[it] = *(const GAS u32x4*)(rp + PC_VA + kv * 64 + 8 * c);
        }
#pragma unroll
        for (int it = 0; it < 6; ++it) {
            const int key = (tid >> 3) + 64 * it;
            const int kpos = (nb - 1) * 128 + key;
            const bool ok = kpos >= 0 && kpos < S;
            u32x4 kr = krs[it], vr = vrs[it];
            if (!ok) { kr = (u32x4){0u, 0u, 0u, 0u}; vr = (u32x4){0u, 0u, 0u, 0u}; }
            float kf[8] = {bf_lo(kr.x), bf_hi(kr.x), bf_lo(kr.y), bf_hi(kr.y), bf_lo(kr.z), bf_hi(kr.z), bf_lo(kr.w), bf_hi(kr.w)};
            float ss = 0.f;
#pragma unroll
            for (int j = 0; j < 8; ++j) ss += kf[j] * kf[j];
            ss = DPP_ADD(ss, 0xB1, 0xF); ss = DPP_ADD(ss, 0x4E, 0xF); ss = DPP_ADD(ss, 0x141, 0xF);
            const float rs = rsqrtf(ss * (1.f / 64.f) + 1e-6f);
            u32x4 kn; kn.x = pk2(kf[0] * rs * g0.x, kf[1] * rs * g0.y); kn.y = pk2(kf[2] * rs * g0.z, kf[3] * rs * g0.w);
            kn.z = pk2(kf[4] * rs * g1.x, kf[5] * rs * g1.y); kn.w = pk2(kf[6] * rs * g1.z, kf[7] * rs * g1.w);
            *(LAS u32x4*)(lds + AT_K_OFF + key * 128 + ((c ^ (key & 7)) << 4)) = kn;
            LAS bf16* vt = (LAS bf16*)(lds + AT_VT_OFF) + (8 * c) * AT_VT_LD + key;
            vt[0 * AT_VT_LD] = (bf16)(vr.x & 0xffff); vt[1 * AT_VT_LD] = (bf16)(vr.x >> 16); vt[2 * AT_VT_LD] = (bf16)(vr.y & 0xffff); vt[3 * AT_VT_LD] = (bf16)(vr.y >> 16);
            vt[4 * AT_VT_LD] = (bf16)(vr.z & 0xffff); vt[5 * AT_VT_LD] = (bf16)(vr.z >> 16); vt[6 * AT_VT_LD] = (bf16)(vr.w & 0xffff); vt[7 * AT_VT_LD] = (bf16)(vr.w >> 16);
        }
        LAS float* tab = (LAS float*)(lds + AT_TAB_OFF);
        for (int i = tid; i < 4 * AT_TAB_LD; i += NWAVES * 64) { const int gg = i / AT_TAB_LD, e = i - gg * AT_TAB_LD; const int rel = e - 160;
            tab[i] = (rel >= -128 && rel <= 128) ? relt[t5_bucket(rel) * 8 + kv * 4 + gg] * LOG2E : 0.f; }
    }
    LDS_WAIT();
    __syncthreads();
    const float sink2 = sink[h] * LOG2E;
    const LAS float* tabh = (const LAS float*)(lds + AT_TAB_OFF) + g * AT_TAB_LD;
    u32x4 cwin[12];
    if (cu0 >= 0) conv_issue(F, a, cu0, cwin);
    for (int grp = 0; grp < 2; ++grp) {
        const int qoff = 64 * (wid & 1) + 32 * grp + r32;
        const size_t qrow = (size_t)b * S + (size_t)nb * 128 + qoff;
        bf16x8 qf[4];
        {
            u32x4 raw[4]; float ss = 0.f;
#pragma unroll
            for (int s = 0; s < 4; ++s) { raw[s] = *(const GAS u32x4*)(PA + qrow * PA_LD + PC_QA + h * 64 + 16 * s + 8 * hi);
                const unsigned w[4] = {raw[s].x, raw[s].y, raw[s].z, raw[s].w};
#pragma unroll
                for (int j = 0; j < 4; ++j) { const float lo = bf_lo(w[j]), hh = bf_hi(w[j]); ss += lo * lo + hh * hh; } }
            ss = x32_sum(ss);
            const float rs = rsqrtf(ss * (1.f / 64.f) + 1e-6f) * (0.125f * LOG2E);
#pragma unroll
            for (int s = 0; s < 4; ++s) { const f32x4 g0 = *(const GAS f32x4*)(qg + 16 * s + 8 * hi), g1 = *(const GAS f32x4*)(qg + 16 * s + 8 * hi + 4);
                u32x4 o; o.x = pk2(bf_lo(raw[s].x) * rs * g0.x, bf_hi(raw[s].x) * rs * g0.y); o.y = pk2(bf_lo(raw[s].y) * rs * g0.z, bf_hi(raw[s].y) * rs * g0.w);
                o.z = pk2(bf_lo(raw[s].z) * rs * g1.x, bf_hi(raw[s].z) * rs * g1.y); o.w = pk2(bf_lo(raw[s].w) * rs * g1.z, bf_hi(raw[s].w) * rs * g1.w);
                qf[s] = __builtin_bit_cast(bf16x8, o); }
        }
        float m = sink2, l = (hi == 0) ? 1.f : 0.f;
        f32x16 o0 = {}, o1 = {};
        const int qoff_g = 64 * (wid & 1) + 32 * grp;
        const int kt0 = qoff_g / 32, klo = (nb == 0 && kt0 < 4) ? 4 : kt0, khi = (nb == 15 && kt0 + 8 > 7) ? 7 : kt0 + 8;
#define AT_QK(dst, ktile) do { dst = (f32x16){}; _Pragma("unroll") for (int s = 0; s < 4; ++s) { const int key = 32 * (ktile) + r32; const int ch = 2 * s + hi; \
            const bf16x8 kfr = *(const LAS bf16x8*)(lds + AT_K_OFF + key * 128 + ((ch ^ (key & 7)) << 4)); dst = __builtin_amdgcn_mfma_f32_32x32x16_bf16(kfr, qf[s], dst, 0, 0, 0); } } while (0)
        for (int kt = klo; kt <= khi; ++kt) {
            const int key0 = 32 * kt;
            f32x16 p; AT_QK(p, kt);
            const int tb = key0 + 4 * hi - qoff + 32;
            float tmax = -3.0e38f;
            if (kt == kt0 || kt == kt0 + 8) {
#pragma unroll
                for (int r = 0; r < 16; ++r) { const int rel = key0 + crow(r, hi) - 128 - qoff;
                    const float sv = (rel >= -128 && rel <= 128) ? p[r] + tabh[tb + (r & 3) + 8 * (r >> 2)] : -1.0e30f;
                    p[r] = sv; tmax = fmaxf(tmax, sv); }
            } else {
#pragma unroll
                for (int r = 0; r < 16; ++r) { const float sv = p[r] + tabh[tb + (r & 3) + 8 * (r >> 2)]; p[r] = sv; tmax = fmaxf(tmax, sv); }
            }
            tmax = x32_max(tmax);
            const float mn = fmaxf(m, tmax);
            if (__any(mn > m)) { const float al = __builtin_amdgcn_exp2f(m - mn); l *= al;
#pragma unroll
                for (int r = 0; r < 16; ++r) { o0[r] *= al; o1[r] *= al; } }
            m = mn;
            float ps = 0.f;
#pragma unroll
            for (int r = 0; r < 16; ++r) { p[r] = __builtin_amdgcn_exp2f(p[r] - m); ps += p[r]; }
            l += ps;
#pragma unroll
            for (int s = 0; s < 2; ++s) {
                u32x4 pw; pw.x = cvt_pk_bf16(p[8 * s + 0], p[8 * s + 1]); pw.y = cvt_pk_bf16(p[8 * s + 2], p[8 * s + 3]); pw.z = cvt_pk_bf16(p[8 * s + 4], p[8 * s + 5]); pw.w = cvt_pk_bf16(p[8 * s + 6], p[8 * s + 7]);
                const bf16x8 pf = __builtin_bit_cast(bf16x8, pw);
#pragma unroll
                for (int dt = 0; dt < 2; ++dt) {
                    const LAS unsigned char* vp = lds + AT_VT_OFF + (32 * dt + r32) * (AT_VT_LD * 2) + (key0 + 16 * s + 4 * hi) * 2;
                    const u32x2 lo = *(const LAS u32x2*)(vp), hh = *(const LAS u32x2*)(vp + 16);
                    const bf16x8 vf = __builtin_bit_cast(bf16x8, (u32x4){lo.x, lo.y, hh.x, hh.y});
                    if (dt == 0) o0 = __builtin_amdgcn_mfma_f32_32x32x16_bf16(vf, pf, o0, 0, 0, 0); else o1 = __builtin_amdgcn_mfma_f32_32x32x16_bf16(vf, pf, o1, 0, 0, 0);
                }
            }
        }
#undef AT_QK
        l = x32_sum(l);
        const float inv = __builtin_amdgcn_rcpf(l);
        bf16* orow = YA + qrow * 512 + h * 64;
#pragma unroll
        for (int k = 0; k < 4; ++k) {
            u32x2 w0, w1; w0.x = cvt_pk_bf16(o0[4 * k] * inv, o0[4 * k + 1] * inv); w0.y = cvt_pk_bf16(o0[4 * k + 2] * inv, o0[4 * k + 3] * inv);
            w1.x = cvt_pk_bf16(o1[4 * k] * inv, o1[4 * k + 1] * inv); w1.y = cvt_pk_bf16(o1[4 * k + 2] * inv, o1[4 * k + 3] * inv);
            *(GAS u32x2*)(orow + 8 * k + 4 * hi) = w0; *(GAS u32x2*)(orow + 32 + 8 * k + 4 * hi) = w1;
        }
        if (grp == 0) { if (cu0 >= 0) conv_finish(F, a, cu0, cwin); if (cu1 >= 0) conv_issue(F, a, cu1, cwin); }
        else if (cu1 >= 0) conv_finish(F, a, cu1, cwin);
    }
    __syncthreads();
}

__device__ __forceinline__ void p2a_phase(Frame& F, const Args& a) {
    for (int u = F.vcu; u < Bz * 16 * 2; u += F.G) { const int kv = u & 1, nb = (u >> 1) & 15, b = u >> 5; attn_unit(F, a, b, nb, kv, 2 * u, 2 * u + 1); }
}

constexpr int ML_WL = 13824;
constexpr int ML_QQ = 0, ML_KQ = 4096, ML_VV = 8192, ML_SC = 12288;
constexpr int SC_WS = 0, SC_G = 256, SC_INTER = 512, SC_FLOOR = 768, SC_N = 1024;
constexpr int ML_BATON = 8 * ML_WL;
constexpr int ML_BN = ML_BATON + 16384, ML_BM = ML_BN + 512, ML_BFLAG = ML_BM + 16;
static_assert(ML_BFLAG + 16 <= RING_BYTES, "mLSTM LDS");
constexpr float LN_KS = -2.4260151319598084f;
constexpr float KS = 0.08838834764831845f;

__device__ __forceinline__ int ml_off(int row, int ch) { return row * 64 + ((ch ^ ((row >> 2) & 3)) << 4); }
__device__ __forceinline__ s16x4 tr_read(const LAS unsigned char* p) {
    typedef short v4i16_t __attribute__((ext_vector_type(4)));
    return __builtin_bit_cast(s16x4, __builtin_amdgcn_ds_read_tr16_b64_v4i16((LAS v4i16_t*)p));
}
__device__ __forceinline__ bf16x8 cat4(s16x4 a, s16x4 b) { return (bf16x8){a[0], a[1], a[2], a[3], b[0], b[1], b[2], b[3]}; }
__device__ __forceinline__ bf16x8 pack8(float a0, float a1, float a2, float a3, float a4, float a5, float a6, float a7) {
    u32x4 w; w.x = cvt_pk_bf16(a0, a1); w.y = cvt_pk_bf16(a2, a3); w.z = cvt_pk_bf16(a4, a5); w.w = cvt_pk_bf16(a6, a7); return __builtin_bit_cast(bf16x8, w);
}
__device__ __forceinline__ float bfs(short v) { return __builtin_bit_cast(float, ((unsigned)(unsigned short)v) << 16); }

__device__ __forceinline__ void mlstm_chunk(Frame& F, const Args& a, int b, int h, int dir, int es, int j) {
    int lane_ = F.lane; asm volatile("" : "+v"(lane_));
    const int lane = lane_, r32 = lane & 31, hi = lane >> 5, blk = (lane >> 4) & 1, q4 = (lane & 15) >> 2, p = lane & 3;
    LAS unsigned char* wl = F.lds + F.wave * ML_WL;
    LAS float* SCf = (LAS float*)(wl + ML_SC);
    const bf16* PA = (const bf16*)(a.ws + WS_E); const bf16* QC = (const bf16*)(a.ws + WS_D); const float* GM = (const float*)(a.ws + WS_GM);
    const int swzA = (r32 >> 2) & 3;
    const int rd0o = r32 * 64 + ((hi ^ swzA) << 4);
    const int ch = 2 * blk + (p >> 1), bo = 8 * (p & 1);
    LAS unsigned char* trA0 = wl + 512 * hi + 64 * q4 + ((ch ^ (2 * hi)) << 4) + bo;
    LAS unsigned char* trA1 = wl + 512 * hi + 64 * q4 + 256 + ((ch ^ (2 * hi + 1)) << 4) + bo;
    LAS unsigned char* trB0 = wl + 256 * hi + 64 * q4 + ((ch ^ hi) << 4) + bo;
    LAS unsigned char* trB1 = wl + 256 * hi + 64 * q4 + 512 + ((ch ^ (hi + 2)) << 4) + bo;
    LAS unsigned char* stg = wl + (lane >> 2) * 64 + (((lane & 3) ^ ((lane >> 4) & 3)) << 4);
    const int rdq = r32 * 64 + (swzA << 4) + 8 * hi;
    const int lowtok = b * S + (dir ? (S - 64 - 64 * j) : 64 * j);
    const int L0 = dir ? 15 - (lane >> 2) : (lane >> 2);
    const unsigned voQ = (unsigned)(L0 * 2048 + 16 * (lane & 3)), voP = (unsigned)(L0 * (PA_LD * 2) + 16 * (lane & 3));
#define ML_UG(it) (16 * (dir ? 3 - (it) : (it)))
#define ML_QPTR(it, col) ((const char*)QC + ((size_t)(lowtok + ML_UG(it)) * 1024 + (size_t)(col)) * 2 + voQ)
    float bcum, gval, Gmax, b_last, G63;
    {
        const float* gp = (const float*)((const char*)GM + ((size_t)lowtok * 16 + dir * 8 + h) * 4 + (unsigned)((dir ? 63 - lane : lane) * 64));
        const float ig = gp[0], fg = gp[4];
        const float lf = fminf(fg, 0.f) - 0.6931471805599453f * __builtin_amdgcn_logf(1.f + __builtin_amdgcn_exp2f(-1.4426950408889634f * fabsf(fg)));
#define ML_DPP(v, idn, ctrl, rm) __builtin_bit_cast(float, __builtin_amdgcn_update_dpp(__builtin_bit_cast(int, (float)(idn)), __builtin_bit_cast(int, (v)), (ctrl), (rm), 0xF, false))
        bcum = lf;
        bcum += ML_DPP(bcum, 0.f, 0x111, 0xF); bcum += ML_DPP(bcum, 0.f, 0x112, 0xF); bcum += ML_DPP(bcum, 0.f, 0x114, 0xF); bcum += ML_DPP(bcum, 0.f, 0x118, 0xF);
        bcum += ML_DPP(bcum, 0.f, 0x142, 0xA); bcum += ML_DPP(bcum, 0.f, 0x143, 0xC);
        gval = ig - bcum; Gmax = gval;
        Gmax = fmaxf(Gmax, ML_DPP(Gmax, -3.0e38f, 0x111, 0xF)); Gmax = fmaxf(Gmax, ML_DPP(Gmax, -3.0e38f, 0x112, 0xF)); Gmax = fmaxf(Gmax, ML_DPP(Gmax, -3.0e38f, 0x114, 0xF)); Gmax = fmaxf(Gmax, ML_DPP(Gmax, -3.0e38f, 0x118, 0xF));
        Gmax = fmaxf(Gmax, ML_DPP(Gmax, -3.0e38f, 0x142, 0xA)); Gmax = fmaxf(Gmax, ML_DPP(Gmax, -3.0e38f, 0x143, 0xC));
#undef ML_DPP
        b_last = __builtin_bit_cast(float, __builtin_amdgcn_readlane(__builtin_bit_cast(int, bcum), 63)); G63 = __builtin_bit_cast(float, __builtin_amdgcn_readlane(__builtin_bit_cast(int, Gmax), 63));
        SCf[SC_WS / 4 + lane] = __expf(gval - G63); SCf[SC_G / 4 + lane] = gval;
    }
    asm volatile("" ::: "memory"); __builtin_amdgcn_sched_barrier(0);
#pragma unroll
    for (int it = 0; it < 4; ++it) { const u32x4 v = *(const GAS u32x4*)((const char*)PA + ((size_t)(lowtok + ML_UG(it)) * PA_LD + PC_VM + h * 128 + es * 32) * 2 + voP);
        *(LAS u32x4*)(stg + ML_VV + 1024 * it) = v; }
    asm volatile("" ::: "memory"); __builtin_amdgcn_sched_barrier(0);
    f32x16 ST[2][2]; f32x16 dC[4]; f32x16 dn = {};
#pragma unroll
    for (int x = 0; x < 2; ++x)
#pragma unroll
        for (int y = 0; y < 2; ++y) ST[x][y] = (f32x16){};
#pragma unroll
    for (int x = 0; x < 4; ++x) dC[x] = (f32x16){};
    bf16x8 wvf[4]; u32x4 wsp[4];
#pragma unroll
    for (int ks = 0; ks < 4; ++ks) {
        const s16x4 v0 = tr_read(trA0 + ML_VV + 1024 * ks), v1 = tr_read(trA1 + ML_VV + 1024 * ks);
        const f32x4 w0 = *(const LAS f32x4*)(SCf + SC_WS / 4 + 16 * ks + 8 * hi), w1 = *(const LAS f32x4*)(SCf + SC_WS / 4 + 16 * ks + 8 * hi + 4);
        wvf[ks] = pack8(bfs(v0[0]) * w0.x, bfs(v0[1]) * w0.y, bfs(v0[2]) * w0.z, bfs(v0[3]) * w0.w, bfs(v1[0]) * w1.x, bfs(v1[1]) * w1.y, bfs(v1[2]) * w1.z, bfs(v1[3]) * w1.w);
        wsp[ks] = (u32x4){cvt_pk_bf16(w0.x, w0.y), cvt_pk_bf16(w0.z, w0.w), cvt_pk_bf16(w1.x, w1.y), cvt_pk_bf16(w1.z, w1.w)};
    }
    u32x4 pq[4], pk[4];
#pragma unroll
    for (int it = 0; it < 4; ++it) { pq[it] = *(const GAS u32x4*)ML_QPTR(it, h * 128); pk[it] = *(const GAS u32x4*)ML_QPTR(it, 512 + h * 128); }
#pragma unroll
    for (int q = 0; q < 4; ++q) {
        asm volatile("" ::: "memory"); __builtin_amdgcn_sched_barrier(0);
#pragma unroll
        for (int it = 0; it < 4; ++it) { *(LAS u32x4*)(stg + ML_QQ + 1024 * it) = pq[it]; *(LAS u32x4*)(stg + ML_KQ + 1024 * it) = pk[it]; }
        if (q < 3) {
#pragma unroll
            for (int it = 0; it < 4; ++it) { pq[it] = *(const GAS u32x4*)ML_QPTR(it, h * 128 + 32 * (q + 1)); pk[it] = *(const GAS u32x4*)ML_QPTR(it, 512 + h * 128 + 32 * (q + 1)); }
        } else {
#pragma unroll
            for (int it = 0; it < 4; ++it) pq[it] = *(const GAS u32x4*)ML_QPTR(it, h * 128);
        }
        asm volatile("" ::: "memory"); __builtin_amdgcn_sched_barrier(0);
#pragma unroll
        for (int ks = 0; ks < 2; ++ks) {
            bf16x8 kf[2], qf[2];
            LAS unsigned char* rr = wl + (ks ? (rd0o ^ 32) : rd0o);
#pragma unroll
            for (int x = 0; x < 2; ++x) { kf[x] = *(const LAS bf16x8*)(rr + ML_KQ + 2048 * x); qf[x] = *(const LAS bf16x8*)(rr + ML_QQ + 2048 * x); }
#pragma unroll
            for (int st = 0; st < 2; ++st)
#pragma unroll
                for (int tt = 0; tt < 2; ++tt) ST[st][tt] = __builtin_amdgcn_mfma_f32_32x32x16_bf16(kf[st], qf[tt], ST[st][tt], 0, 0, 0);
        }
#pragma unroll
        for (int ks = 0; ks < 4; ++ks) {
            const bf16x8 ka = cat4(tr_read(trA0 + ML_KQ + 1024 * ks), tr_read(trA1 + ML_KQ + 1024 * ks));
            const bf16x8 wv = wvf[ks];
            const bool selq = (r32 == q);
            const bf16x8 wn = __builtin_bit_cast(bf16x8, (u32x4){selq ? wsp[ks].x : 0u, selq ? wsp[ks].y : 0u, selq ? wsp[ks].z : 0u, selq ? wsp[ks].w : 0u});
            dC[q] = __builtin_amdgcn_mfma_f32_32x32x16_bf16(ka, wv, dC[q], 0, 0, 0);
            dn = __builtin_amdgcn_mfma_f32_32x32x16_bf16(ka, wn, dn, 0, 0, 0);
        }
    }
    u32x4 STp[2][2][2];
#pragma unroll
    for (int st = 0; st < 2; ++st)
#pragma unroll
        for (int tt = 0; tt < 2; ++tt)
#pragma unroll
            for (int ks = 0; ks < 2; ++ks) STp[st][tt][ks] = (u32x4){cvt_pk_bf16(ST[st][tt][8 * ks], ST[st][tt][8 * ks + 1]), cvt_pk_bf16(ST[st][tt][8 * ks + 2], ST[st][tt][8 * ks + 3]), cvt_pk_bf16(ST[st][tt][8 * ks + 4], ST[st][tt][8 * ks + 5]), cvt_pk_bf16(ST[st][tt][8 * ks + 6], ST[st][tt][8 * ks + 7])};
    asm volatile("" ::: "memory"); __builtin_amdgcn_sched_barrier(0);
    volatile LAS unsigned* flag = (volatile LAS unsigned*)(F.lds + ML_BFLAG);
    while (*flag != (unsigned)j) __builtin_amdgcn_s_sleep(1);
    asm volatile("" ::: "memory");
    LAS float* BC = (LAS float*)(F.lds + ML_BATON) + lane * 4; LAS float* BN = (LAS float*)(F.lds + ML_BN); LAS float* BMp = (LAS float*)(F.lds + ML_BM);
    const float m_prev = BMp[0];
    const float M63 = fmaxf(m_prev, G63);
    const float decay = __expf(m_prev - M63), fsc = __expf(G63 - M63) * KS;
    u32x4 Cb[4][2];
#pragma unroll
    for (int dt = 0; dt < 4; ++dt) {
        f32x4 c[4];
#pragma unroll
        for (int k = 0; k < 4; ++k) c[k] = *(const LAS f32x4*)(BC + (dt * 4 + k) * 256);
        Cb[dt][0] = (u32x4){cvt_pk_bf16(c[0].x, c[0].y), cvt_pk_bf16(c[0].z, c[0].w), cvt_pk_bf16(c[1].x, c[1].y), cvt_pk_bf16(c[1].z, c[1].w)};
        Cb[dt][1] = (u32x4){cvt_pk_bf16(c[2].x, c[2].y), cvt_pk_bf16(c[2].z, c[2].w), cvt_pk_bf16(c[3].x, c[3].y), cvt_pk_bf16(c[3].z, c[3].w)};
#pragma unroll
        for (int k = 0; k < 4; ++k) { f32x4 nw; nw.x = decay * c[k].x + fsc * dC[dt][4 * k]; nw.y = decay * c[k].y + fsc * dC[dt][4 * k + 1]; nw.z = decay * c[k].z + fsc * dC[dt][4 * k + 2]; nw.w = decay * c[k].w + fsc * dC[dt][4 * k + 3];
            *(LAS f32x4*)(BC + (dt * 4 + k) * 256) = nw; }
    }
    {
        const float n0 = BN[lane], n1 = BN[lane + 64];
        SCf[SC_N / 4 + lane] = n0; SCf[SC_N / 4 + lane + 64] = n1;
        LDS_WAIT();
        if (r32 < 4) {
#pragma unroll
            for (int k = 0; k < 4; ++k) { const int d0 = 32 * r32 + 8 * k + 4 * hi; const f32x4 np = *(const LAS f32x4*)(SCf + SC_N / 4 + d0);
                f32x4 nw; nw.x = decay * np.x + fsc * dn[4 * k]; nw.y = decay * np.y + fsc * dn[4 * k + 1]; nw.z = decay * np.z + fsc * dn[4 * k + 2]; nw.w = decay * np.w + fsc * dn[4 * k + 3];
                *(LAS f32x4*)(BN + d0) = nw; }
        }
        if (lane == 0) BMp[0] = b_last + M63;
    }
    LDS_WAIT();
    asm volatile("" ::: "memory");
    if (lane == 0) *flag = (unsigned)(j + 1);
    asm volatile("" ::: "memory");
    asm volatile("" ::: "memory"); __builtin_amdgcn_sched_barrier(0);
    const float Mrow = fmaxf(m_prev, Gmax);
    SCf[SC_INTER / 4 + lane] = __expf(m_prev - Mrow); SCf[SC_FLOOR / 4 + lane] = __expf(-bcum - Mrow);
    asm volatile("" ::: "memory"); __builtin_amdgcn_sched_barrier(0);
    f32x16 Z[2], dI[2];
    Z[0] = (f32x16){}; Z[1] = (f32x16){}; dI[0] = (f32x16){}; dI[1] = (f32x16){};
    const bf16x8 ones = (bf16x8){0x3F80, 0x3F80, 0x3F80, 0x3F80, 0x3F80, 0x3F80, 0x3F80, 0x3F80};
    float ex2[2]; ex2[0] = __expf(G63 - __shfl(Mrow, r32) + LN_KS); ex2[1] = __expf(G63 - __shfl(Mrow, r32 + 32) + LN_KS);
#pragma unroll
    for (int st = 0; st < 2; ++st)
#pragma unroll
        for (int ks = 0; ks < 2; ++ks) {
            const bf16x8 vb = cat4(tr_read(trB0 + ML_VV + 2048 * st + 1024 * ks), tr_read(trB1 + ML_VV + 2048 * st + 1024 * ks));
            const int s0 = 32 * st + 16 * ks + 4 * hi;
            const f32x4 ga = *(const LAS f32x4*)(SCf + SC_WS / 4 + s0), gb = *(const LAS f32x4*)(SCf + SC_WS / 4 + s0 + 8);
            const float gg[8] = {ga.x, ga.y, ga.z, ga.w, gb.x, gb.y, gb.z, gb.w};
#pragma unroll
            for (int tt = 0; tt < 2; ++tt) {
                const int t = 32 * tt + r32; const u32x4 sp = STp[st][tt][ks];
                const float sv[8] = {bf_lo(sp.x), bf_hi(sp.x), bf_lo(sp.y), bf_hi(sp.y), bf_lo(sp.z), bf_hi(sp.z), bf_lo(sp.w), bf_hi(sp.w)};
                float pw[8];
#pragma unroll
                for (int jj = 0; jj < 8; ++jj) { const int s = s0 + (jj & 3) + 8 * (jj >> 2); pw[jj] = (s <= t) ? sv[jj] * (gg[jj] * ex2[tt]) : 0.f; }
                const bf16x8 pa = pack8(pw[0], pw[1], pw[2], pw[3], pw[4], pw[5], pw[6], pw[7]);
                Z[tt] = __builtin_amdgcn_mfma_f32_32x32x16_bf16(pa, vb, Z[tt], 0, 0, 0);
                dI[tt] = __builtin_amdgcn_mfma_f32_32x32x16_bf16(pa, ones, dI[tt], 0, 0, 0);
            }
        }
    asm volatile("" ::: "memory"); __builtin_amdgcn_sched_barrier(0);
    f32x16 QCa[2], dN[2];
    QCa[0] = (f32x16){}; QCa[1] = (f32x16){}; dN[0] = (f32x16){}; dN[1] = (f32x16){};
#pragma unroll
    for (int q = 0; q < 4; ++q) {
        asm volatile("" ::: "memory"); __builtin_amdgcn_sched_barrier(0);
#pragma unroll
        for (int it = 0; it < 4; ++it) *(LAS u32x4*)(stg + ML_QQ + 1024 * it) = pq[it];
        if (q < 3) {
#pragma unroll
            for (int it = 0; it < 4; ++it) pq[it] = *(const GAS u32x4*)ML_QPTR(it, h * 128 + 32 * (q + 1));
        }
        asm volatile("" ::: "memory"); __builtin_amdgcn_sched_barrier(0);
#pragma unroll
        for (int ks = 0; ks < 2; ++ks) {
            const int d0 = 32 * q + 16 * ks + 4 * hi;
            const f32x4 na = *(const LAS f32x4*)(SCf + SC_N / 4 + d0), nb2 = *(const LAS f32x4*)(SCf + SC_N / 4 + d0 + 8);
            const bf16x8 nf = pack8(na.x, na.y, na.z, na.w, nb2.x, nb2.y, nb2.z, nb2.w);
            const bf16x8 cf = __builtin_bit_cast(bf16x8, Cb[q][ks]);
#pragma unroll
            for (int tt = 0; tt < 2; ++tt) {
                const u32x2 lo = *(const LAS u32x2*)(wl + ML_QQ + 2048 * tt + (rdq ^ (32 * ks))), hh = *(const LAS u32x2*)(wl + ML_QQ + 2048 * tt + (rdq ^ (32 * ks + 16)));
                const bf16x8 qa = __builtin_bit_cast(bf16x8, (u32x4){lo.x, lo.y, hh.x, hh.y});
                QCa[tt] = __builtin_amdgcn_mfma_f32_32x32x16_bf16(qa, cf, QCa[tt], 0, 0, 0);
                dN[tt] = __builtin_amdgcn_mfma_f32_32x32x16_bf16(qa, nf, dN[tt], 0, 0, 0);
            }
        }
    }
    LDS_WAIT();
    asm volatile("" ::: "memory"); __builtin_amdgcn_sched_barrier(0);
    {
        const int wbo = 256 * hi + (((r32 >> 3) ^ hi) << 4) + 2 * (r32 & 7);
#pragma unroll
        for (int tt = 0; tt < 2; ++tt)
#pragma unroll
            for (int k = 0; k < 4; ++k) { const int t0 = 32 * tt + 8 * k + 4 * hi;
                const f32x4 iv = *(const LAS f32x4*)(SCf + SC_INTER / 4 + t0), fv = *(const LAS f32x4*)(SCf + SC_FLOOR / 4 + t0);
                const float ii[4] = {iv.x, iv.y, iv.z, iv.w}, ff[4] = {fv.x, fv.y, fv.z, fv.w};
#pragma unroll
                for (int e = 0; e < 4; ++e) { const int r = 4 * k + e; const float num = Z[tt][r] + ii[e] * QCa[tt][r], den = dI[tt][r] + ii[e] * dN[tt][r];
                    const float hv = num * __builtin_amdgcn_rcpf(fmaxf(fabsf(den), ff[e]));
                    *(LAS bf16*)(wl + ML_QQ + ((k & 1) ? (wbo ^ 32) : wbo) + 64 * (32 * tt + 8 * k + e)) = (bf16)(cvt_pk_bf16(hv, 0.f) & 0xffffu); } }
    }
    LDS_WAIT();
    asm volatile("" ::: "memory");
    bf16* HO = (bf16*)(a.ws + WS_E);
    const int ocol = (dir ? PC_KM : PC_QM) + h * 128 + es * 32;
#pragma unroll
    for (int it = 0; it < 4; ++it) {
        const u32x4 v = *(const LAS u32x4*)(stg + ML_QQ + 1024 * it);
        *(GAS u32x4*)((char*)HO + ((size_t)(lowtok + ML_UG(it)) * PA_LD + ocol) * 2 + voP) = v; }
    LDS_WAIT();
    asm volatile("" ::: "memory");
}

#undef ML_UG
#undef ML_QPTR
__device__ __forceinline__ void p2m_phase(Frame& F, const Args& a) {
    for (int u = F.vcu; u < Bz * 4 * 2 * 4; u += F.G) {
        const int es = u & 3, dir = (u >> 2) & 1, h = (u >> 3) & 3, b = u >> 5;
        for (int i = F.tid; i < (16384 + 512 + 32) / 4; i += NWAVES * 64) ((LAS unsigned*)(F.lds + ML_BATON))[i] = 0u;
        LDS_WAIT();
        __syncthreads();
        for (int i = 0; i < 4; ++i) mlstm_chunk(F, a, b, h, dir, es, 8 * i + F.wave);
        __syncthreads();
    }
}

__device__ __forceinline__ void p2b_phase(Frame& F, const Args& a) {
    bf16* PA = (bf16*)(a.ws + WS_E); const float* og = a.in[10];
    const int gw = F.vcu * NWAVES + F.wave, NGW = F.G * NWAVES, lane = F.lane;
    const f32x4 g0 = *(const GAS f32x4*)(og + 8 * lane), g1 = *(const GAS f32x4*)(og + 8 * lane + 4);
    for (int t = gw; t < T; t += NGW) {
        bf16* row = PA + (size_t)t * PA_LD;
        const u32x4 hf = *(const GAS u32x4*)(row + PC_QM + 8 * lane), hb = *(const GAS u32x4*)(row + PC_KM + 8 * lane), om = *(const GAS u32x4*)(row + PC_OM + 8 * lane);
        float v[8] = {bf_lo(hf.x) + bf_lo(hb.x), bf_hi(hf.x) + bf_hi(hb.x), bf_lo(hf.y) + bf_lo(hb.y), bf_hi(hf.y) + bf_hi(hb.y), bf_lo(hf.z) + bf_lo(hb.z), bf_hi(hf.z) + bf_hi(hb.z), bf_lo(hf.w) + bf_lo(hb.w), bf_hi(hf.w) + bf_hi(hb.w)};
        float ss = 0.f;
#pragma unroll
        for (int e = 0; e < 8; ++e) ss += v[e] * v[e];
        ss += __shfl_xor(ss, 1); ss += __shfl_xor(ss, 2); ss += __shfl_xor(ss, 4); ss += __shfl_xor(ss, 8);
        const float rs = rsqrtf(ss * (1.f / 128.f) + 1e-6f);
        const float o[8] = {bf_lo(om.x), bf_hi(om.x), bf_lo(om.y), bf_hi(om.y), bf_lo(om.z), bf_hi(om.z), bf_lo(om.w), bf_hi(om.w)};
        const float gg[8] = {g0.x, g0.y, g0.z, g0.w, g1.x, g1.y, g1.z, g1.w};
#pragma unroll
        for (int e = 0; e < 8; ++e) v[e] = v[e] * rs * gg[e] * sigm(o[e]);
        u32x4 w; w.x = cvt_pk_bf16(v[0], v[1]); w.y = cvt_pk_bf16(v[2], v[3]); w.z = cvt_pk_bf16(v[4], v[5]); w.w = cvt_pk_bf16(v[6], v[7]);
        if (!a.dry) *(GAS u32x4*)(row + PC_OM + 8 * lane) = w; else asm volatile("" :: "v"(w));
    }
}

__device__ __forceinline__ void p2b_rows(Frame& F, const Args& a, int row0, unsigned* pcnt) {
    bf16* PA = (bf16*)(a.ws + WS_E); const float* og = a.in[10];
    const int lane = F.lane;
    const f32x4 g0 = *(const GAS f32x4*)(og + 8 * lane), g1 = *(const GAS f32x4*)(og + 8 * lane + 4);
    const float gg[8] = {g0.x, g0.y, g0.z, g0.w, g1.x, g1.y, g1.z, g1.w};
    const __amdgpu_buffer_rsrc_t rsrc = __builtin_amdgcn_make_buffer_rsrc((void*)PA, 0, (int)((size_t)T * PA_LD * 2), 0x00020000);
    u32x4 hf[8], hb[8], om[8];
#pragma unroll
    for (int i = 0; i < 8; ++i) { const bf16* row = PA + (size_t)(row0 + F.wave * 8 + i) * PA_LD;
        hf[i] = *(const GAS u32x4*)(row + PC_QM + 8 * lane); hb[i] = *(const GAS u32x4*)(row + PC_KM + 8 * lane); om[i] = *(const GAS u32x4*)(row + PC_OM + 8 * lane); }
#pragma unroll
    for (int i = 0; i < 8; ++i) {
        float v[8] = {bf_lo(hf[i].x) + bf_lo(hb[i].x), bf_hi(hf[i].x) + bf_hi(hb[i].x), bf_lo(hf[i].y) + bf_lo(hb[i].y), bf_hi(hf[i].y) + bf_hi(hb[i].y), bf_lo(hf[i].z) + bf_lo(hb[i].z), bf_hi(hf[i].z) + bf_hi(hb[i].z), bf_lo(hf[i].w) + bf_lo(hb[i].w), bf_hi(hf[i].w) + bf_hi(hb[i].w)};
        float ss = 0.f;
#pragma unroll
        for (int e = 0; e < 8; ++e) ss += v[e] * v[e];
        ss = DPP_ADD(ss, 0xB1, 0xF); ss = DPP_ADD(ss, 0x4E, 0xF); ss = DPP_ADD(ss, 0x141, 0xF); ss = DPP_ADD(ss, 0x140, 0xF);
        const float rs = rsqrtf(ss * (1.f / 128.f) + 1e-6f);
        const float o[8] = {bf_lo(om[i].x), bf_hi(om[i].x), bf_lo(om[i].y), bf_hi(om[i].y), bf_lo(om[i].z), bf_hi(om[i].z), bf_lo(om[i].w), bf_hi(om[i].w)};
#pragma unroll
        for (int e = 0; e < 8; ++e) v[e] = v[e] * rs * gg[e] * sigm(o[e]);
        u32x4 w; w.x = cvt_pk_bf16(v[0], v[1]); w.y = cvt_pk_bf16(v[2], v[3]); w.z = cvt_pk_bf16(v[4], v[5]); w.w = cvt_pk_bf16(v[6], v[7]);
        __builtin_amdgcn_raw_buffer_store_b128(w, rsrc, (int)(((size_t)(row0 + F.wave * 8 + i) * PA_LD + PC_OM + 8 * lane) * 2), 0, 16);
    }
    asm volatile("s_waitcnt vmcnt(0)" ::: "memory");
    if (lane == 0) __hip_atomic_fetch_add(pcnt, 1u, __ATOMIC_RELAXED, __HIP_MEMORY_SCOPE_AGENT);
}


struct SchedP3a {
    int G, c; const char* PAb; const char* WaT; const char* WmT; const char* YAb; unsigned* pcnt; unsigned* tmo;
    __device__ __forceinline__ void a_ready(const Unit& u) const {
        if (!u.aux) return;
        if (threadIdx.x < 64) {
            unsigned polls = 0;
            while ((unsigned)__builtin_amdgcn_readfirstlane(__hip_atomic_load(pcnt + 64 * u.pm, __ATOMIC_RELAXED, __HIP_MEMORY_SCOPE_AGENT)) < 32u) {
                __builtin_amdgcn_s_sleep(2);
                if ((++polls & 1023u) == 0u) { if (__builtin_amdgcn_readfirstlane(__hip_atomic_load(tmo, __ATOMIC_RELAXED, __HIP_MEMORY_SCOPE_AGENT)) != 0u) break;
                    if (polls > (1u << 22)) { if (threadIdx.x == 0) __hip_atomic_store(tmo, 1u, __ATOMIC_RELAXED, __HIP_MEMORY_SCOPE_AGENT); break; } }
            }
            __builtin_amdgcn_fence(__ATOMIC_ACQUIRE, "agent");
            asm volatile("s_waitcnt vmcnt(0)" ::: "memory");
        }
        asm volatile("" ::: "memory"); __builtin_amdgcn_s_barrier(); asm volatile("" ::: "memory");
    }
    __device__ __forceinline__ bool next(int i, Unit& u) const {
        if (!tile_order(i >> 1, G, c, T / BM, D / BM, u.pm, u.pn)) return false;
        u.aux = i & 1;
        u.A = u.aux ? PAb + (size_t)u.pm * BM * PA_LD * 2 + PC_OM * 2 : YAb + (size_t)u.pm * BM * 512 * 2;
        u.B = (u.aux ? WmT : WaT) + (size_t)u.pn * BM * 512 * 2; return true;
    }
    __device__ __forceinline__ void lane_offs(const Unit& u, int tid, unsigned (&vo)[2][2]) const {
        const int ld = u.aux ? PA_LD : 512;
#pragma unroll
        for (int i = 0; i < 2; ++i) { int R, C; stage_rc(tid * 16 + i * 8192, R, C); vo[0][i] = (unsigned)(R * ld + C) * 2u; vo[1][i] = (unsigned)((R + HALF) * ld + C) * 2u; }
    }
};
struct EpiP3a {
    static constexpr bool PERM = true;
    bf16* U; const bf16* MG; unsigned* pcu;
    __device__ __forceinline__ void operator()(const f32x4 (&acc)[2][2][4][2], const Unit& u, int wr, int wc, int fr, int fq) const {
        const int row0 = u.pm * BM + wr * 64 + fr, col0 = u.pn * BM + wc * 32 + 8 * fq;
        if (!u.aux) {
#pragma unroll
            for (int ai = 0; ai < 2; ++ai) {
                u32x4 g[4][2];
#pragma unroll
                for (int m = 0; m < 4; ++m)
#pragma unroll
                    for (int bj = 0; bj < 2; ++bj) g[m][bj] = *(const GAS u32x4*)(MG + (size_t)(row0 + ai * HALF + m * 16) * 2048 + col0 + bj * HALF);
#pragma unroll
                for (int m = 0; m < 4; ++m)
#pragma unroll
                    for (int bj = 0; bj < 2; ++bj) { const u32x4 gg = g[m][bj]; const f32x4 v0 = acc[ai][bj][m][0], v1 = acc[ai][bj][m][1];
                        u32x4 w; w.x = cvt_pk_bf16(v0[0] * bf_lo(gg.x), v0[1] * bf_hi(gg.x)); w.y = cvt_pk_bf16(v0[2] * bf_lo(gg.y), v0[3] * bf_hi(gg.y));
                        w.z = cvt_pk_bf16(v1[0] * bf_lo(gg.z), v1[1] * bf_hi(gg.z)); w.w = cvt_pk_bf16(v1[2] * bf_lo(gg.w), v1[3] * bf_hi(gg.w));
                        *(GAS u32x4*)(U + (size_t)(row0 + ai * HALF + m * 16) * D + col0 + bj * HALF) = w; }
            }
        } else {
            const __amdgpu_buffer_rsrc_t rsrc = __builtin_amdgcn_make_buffer_rsrc((void*)U, 0, (int)((size_t)T * D * 2), 0x00020000);
#pragma unroll
            for (int ai = 0; ai < 2; ++ai) {
                u32x4 g[4][2], pv[4][2];
#pragma unroll
                for (int m = 0; m < 4; ++m)
#pragma unroll
                    for (int bj = 0; bj < 2; ++bj) { g[m][bj] = *(const GAS u32x4*)(MG + (size_t)(row0 + ai * HALF + m * 16) * 2048 + 1024 + col0 + bj * HALF);
                        pv[m][bj] = *(const GAS u32x4*)(U + (size_t)(row0 + ai * HALF + m * 16) * D + col0 + bj * HALF); }
#pragma unroll
                for (int m = 0; m < 4; ++m)
#pragma unroll
                    for (int bj = 0; bj < 2; ++bj) { const u32x4 gg = g[m][bj], pp = pv[m][bj]; const f32x4 v0 = acc[ai][bj][m][0], v1 = acc[ai][bj][m][1];
                        u32x4 w; w.x = cvt_pk_bf16(bf_lo(pp.x) + v0[0] * bf_lo(gg.x), bf_hi(pp.x) + v0[1] * bf_hi(gg.x)); w.y = cvt_pk_bf16(bf_lo(pp.y) + v0[2] * bf_lo(gg.y), bf_hi(pp.y) + v0[3] * bf_hi(gg.y));
                        w.z = cvt_pk_bf16(bf_lo(pp.z) + v1[0] * bf_lo(gg.z), bf_hi(pp.z) + v1[1] * bf_hi(gg.z)); w.w = cvt_pk_bf16(bf_lo(pp.w) + v1[2] * bf_lo(gg.w), bf_hi(pp.w) + v1[3] * bf_hi(gg.w));
                        __builtin_amdgcn_raw_buffer_store_b128(w, rsrc, (int)(((size_t)(row0 + ai * HALF + m * 16) * D + col0 + bj * HALF) * 2), 0, 16); }
            }
            asm volatile("s_waitcnt vmcnt(0)" ::: "memory");
            if ((threadIdx.x & 63) == 0) __hip_atomic_fetch_add(pcu + 64 * u.pm, 1u, __ATOMIC_RELAXED, __HIP_MEMORY_SCOPE_AGENT);
        }
    }
};
struct SchedP3b {
    int G, c; const char* A; const char* B; unsigned* pcu; unsigned* tmo;
    __device__ __forceinline__ void a_ready(const Unit& u) const { panel_wait(pcu + 64 * u.pm, 32u, tmo); }
    __device__ __forceinline__ bool next(int i, Unit& u) const { if (!tile_order(i, G, c, T / BM, D / BM, u.pm, u.pn)) return false; u.aux = 0; u.A = A + (size_t)u.pm * BM * D * 2; u.B = B + (size_t)u.pn * BM * D * 2; return true; }
    __device__ __forceinline__ void lane_offs(const Unit&, int tid, unsigned (&vo)[2][2]) const {
#pragma unroll
        for (int i = 0; i < 2; ++i) { int R, C; stage_rc(tid * 16 + i * 8192, R, C); vo[0][i] = (unsigned)(R * D + C) * 2u; vo[1][i] = (unsigned)((R + HALF) * D + C) * 2u; }
    }
};
struct EpiP3b {
    static constexpr bool PERM = true;
    bf16* TB; unsigned* pct;
    __device__ __forceinline__ void operator()(const f32x4 (&acc)[2][2][4][2], const Unit& u, int wr, int wc, int fr, int fq) const {
        const int row0 = u.pm * BM + wr * 64 + fr, col0 = u.pn * BM + wc * 32 + 8 * fq;
        const __amdgpu_buffer_rsrc_t rsrc = __builtin_amdgcn_make_buffer_rsrc((void*)TB, 0, (int)((size_t)T * 2048 * 2), 0x00020000);
#pragma unroll
        for (int ai = 0; ai < 2; ++ai)
#pragma unroll
            for (int m = 0; m < 4; ++m) { const size_t ro = (size_t)(row0 + ai * HALF + m * 16) * 2048 + col0;
#pragma unroll
                for (int bj = 0; bj < 2; ++bj) { const f32x4 v0 = acc[ai][bj][m][0], v1 = acc[ai][bj][m][1];
                    u32x4 w; w.x = cvt_pk_bf16(v0[0], v0[1]); w.y = cvt_pk_bf16(v0[2], v0[3]); w.z = cvt_pk_bf16(v1[0], v1[1]); w.w = cvt_pk_bf16(v1[2], v1[3]);
                    __builtin_amdgcn_raw_buffer_store_b128(w, rsrc, (int)((ro + bj * HALF) * 2), 0, 16); } }
        asm volatile("s_waitcnt vmcnt(0)" ::: "memory");
        if ((threadIdx.x & 63) == 0) __hip_atomic_fetch_add(pct + 64 * u.pm, 1u, __ATOMIC_RELAXED, __HIP_MEMORY_SCOPE_AGENT);
    }
};

constexpr size_t TOK_E = 0, TOK_W = 131072, TOK_SLOT = 262144, TOK_LIST = 524288;
constexpr int RW_LD = 36;
__device__ __forceinline__ void p4_phase(Frame& F, const Args& a) {
    const float* g2 = a.in[15]; const float* wrg = a.in[16]; const float* brg = a.in[17]; const float* wre = a.in[18]; const float* bre = a.in[19];
    bf16* H2 = (bf16*)(a.ws + WS_D);
    int* tok_e = (int*)(a.ws + WS_TOK + TOK_E); float* tok_w = (float*)(a.ws + WS_TOK + TOK_W); int* tok_slot = (int*)(a.ws + WS_TOK + TOK_SLOT); int* list = (int*)(a.ws + WS_TOK + TOK_LIST);
    unsigned* cnt = (unsigned*)(F.ctl + CW_CNT);
    LAS float* W = (LAS float*)F.lds;
    LAS unsigned* lcnt = (LAS unsigned*)(F.lds + 148480); LAS unsigned* lbase = lcnt + 32; LAS unsigned* rec = lcnt + 64;
    if (F.tid < 64) lcnt[F.tid] = 0u;
    for (int i = F.tid; i < 1024 * 9; i += NWAVES * 64) { const int row = i / 9, pc = i - row * 9;
        const f32x4 v = pc == 0 ? *(const GAS f32x4*)(wrg + row * 4) : *(const GAS f32x4*)(wre + row * 32 + 4 * (pc - 1));
        *(LAS f32x4*)(W + row * RW_LD + 4 * (row >> 5) + 4 * pc) = v; }
    LDS_WAIT();
    __syncthreads();
    int ppm = 0, ppn = 0; tile_order(0, F.G, (int)blockIdx.x, T / BM, D / BM, ppm, ppn);
    panel_wait((unsigned*)(F.ctl + CW_PANT) + 64 * ppm, 32u, (unsigned*)(F.ctl + CW_TMO));
    const int lane = F.lane, gw = ppm * BM + ppn * 64 + F.wave * 8; constexpr int NGW = 1;
    float gv[16];
#pragma unroll
    for (int m = 0; m < 8; ++m) { const f32x2 t2 = *(const GAS f32x2*)(g2 + 128 * m + 2 * lane); gv[2 * m] = t2.x; gv[2 * m + 1] = t2.y; }
    const float* xin = a.in[0]; const bf16* TBp = (const bf16*)a.out;
    f32x2 nx[8]; unsigned nt[8];
#pragma unroll
    for (int m = 0; m < 8; ++m) { nx[m] = *(const GAS f32x2*)(xin + (size_t)gw * D + 128 * m + 2 * lane); nt[m] = *(const GAS unsigned*)(TBp + (size_t)gw * 2048 + 128 * m + 2 * lane); }
    for (int it = 0; it < 8; ++it) { const int t = gw + NGW * it; if (t >= T) break;
        float y[16]; float ss = 0.f;
#pragma unroll
        for (int m = 0; m < 8; ++m) { y[2 * m] = nx[m].x + bf_lo(nt[m]); y[2 * m + 1] = nx[m].y + bf_hi(nt[m]); ss += y[2 * m] * y[2 * m] + y[2 * m + 1] * y[2 * m + 1]; }
        { const int tn = (t + NGW < T) ? t + NGW : t;
#pragma unroll
          for (int m = 0; m < 8; ++m) { nx[m] = *(const GAS f32x2*)(xin + (size_t)tn * D + 128 * m + 2 * lane); nt[m] = *(const GAS unsigned*)(TBp + (size_t)tn * 2048 + 128 * m + 2 * lane); } }
        if (!a.dry) {
#pragma unroll
            for (int m = 0; m < 8; ++m) *(GAS unsigned*)((bf16*)a.out + (size_t)t * 2048 + 128 * m + 2 * lane) = pk2(y[2 * m], y[2 * m + 1]); }
        const float rstd = rsqrtf(wave_sum(ss) * (1.f / D) + 1e-6f);
#pragma unroll
        for (int m = 0; m < 8; ++m) { y[2 * m] *= rstd * gv[2 * m]; y[2 * m + 1] *= rstd * gv[2 * m + 1];
            *(GAS unsigned*)(H2 + (size_t)t * D + 128 * m + 2 * lane) = pk2(y[2 * m], y[2 * m + 1]); }
        f32x4 gl = {0.f, 0.f, 0.f, 0.f};
#pragma unroll
        for (int m = 0; m < 16; ++m) { const int k = 128 * (m >> 1) + 2 * lane + (m & 1); gl += y[m] * *(const LAS f32x4*)(W + k * RW_LD + 4 * (k >> 5)); }
#pragma unroll
        for (int j = 0; j < 4; ++j) gl[j] = wave_sum(gl[j]) + brg[j];
        int gi = 0; float gm = gl[0];
#pragma unroll
        for (int j = 1; j < 4; ++j) if (gl[j] > gm) { gm = gl[j]; gi = j; }
        gi = __builtin_amdgcn_readfirstlane(gi);
        float gs = 0.f;
#pragma unroll
        for (int j = 0; j < 4; ++j) gs += __expf(gl[j] - gm);
        const float pg = 1.f / gs;
        f32x4 e0 = {0.f, 0.f, 0.f, 0.f}, e1 = {0.f, 0.f, 0.f, 0.f};
#pragma unroll
        for (int m = 0; m < 16; ++m) { const int k = 128 * (m >> 1) + 2 * lane + (m & 1); const LAS float* wr = W + k * RW_LD + 4 * (k >> 5) + 4 + 8 * gi; e0 += y[m] * *(const LAS f32x4*)wr; e1 += y[m] * *(const LAS f32x4*)(wr + 4); }
        float el[8];
#pragma unroll
        for (int j = 0; j < 4; ++j) { el[j] = wave_sum(e0[j]) + bre[8 * gi + j]; el[4 + j] = wave_sum(e1[j]) + bre[8 * gi + 4 + j]; }
        int i1 = 0, i2 = -1; float v1 = el[0], v2 = -3.0e38f;
#pragma unroll
        for (int j = 1; j < 8; ++j) { if (el[j] > v1) { v2 = v1; i2 = i1; v1 = el[j]; i1 = j; } else if (el[j] > v2) { v2 = el[j]; i2 = j; } }
        if (lane == 0) {
            const float ex = __expf(v2 - v1); const float w1 = pg / (1.f + ex), w2 = pg * ex / (1.f + ex);
            const int ea = gi * 8 + i1, eb = gi * 8 + i2;
            const unsigned sa = __hip_atomic_fetch_add(lcnt + ea, 1u, __ATOMIC_RELAXED, __HIP_MEMORY_SCOPE_WORKGROUP), sb = __hip_atomic_fetch_add(lcnt + eb, 1u, __ATOMIC_RELAXED, __HIP_MEMORY_SCOPE_WORKGROUP);
            tok_e[2 * t] = ea; tok_e[2 * t + 1] = eb; tok_w[2 * t] = w1; tok_w[2 * t + 1] = w2;
            LAS unsigned* rc = rec + 4 * (F.wave * 8 + it);
            rc[0] = (unsigned)ea; rc[1] = (unsigned)eb; rc[2] = sa; rc[3] = sb;
        }
    }
    LDS_WAIT();
    __syncthreads();
    if (F.tid < NE) { const unsigned n = lcnt[F.tid]; lbase[F.tid] = (n && !a.dry) ? atomicAdd(&cnt[F.tid], n) : 0u; }
    LDS_WAIT();
    __syncthreads();
    if (lane < 8) { const int t = gw + NGW * lane;
        if (t < T && !a.dry) { const LAS unsigned* rc = rec + 4 * (F.wave * 8 + lane); const unsigned ea = rc[0], eb = rc[1]; const unsigned sa = lbase[ea] + rc[2], sb = lbase[eb] + rc[3];
            tok_slot[2 * t] = (int)sa; tok_slot[2 * t + 1] = (int)sb; list[(size_t)ea * T + sa] = t; list[(size_t)eb * T + sb] = t; } }
    __syncthreads();
}

constexpr int MT_CNT = 0, MT_OFF = 32, MT_TST = 65, MT_TE = 98;
constexpr size_t WS_HID = WS_E, WS_YB = WS_E + 33 * MiB;
__device__ __forceinline__ void moe_tables(Frame& F) {
    volatile LAS int* tb = (volatile LAS int*)(F.lds + MOE_TAB_OFF);
    if (F.tid < 64) {
        const int e = F.tid & 31;
        const int c = (int)__hip_atomic_load((unsigned*)(F.ctl + CW_CNT) + e, __ATOMIC_RELAXED, __HIP_MEMORY_SCOPE_AGENT);
        const int nt = (c + 255) >> 8;
        int off = c, ts = nt;
#pragma unroll
        for (int d = 1; d < 32; d <<= 1) { const int o = __shfl_up(off, d, 32), q = __shfl_up(ts, d, 32); if (e >= d) { off += o; ts += q; } }
        if (F.tid < 32) {
            tb[MT_CNT + e] = c; tb[MT_OFF + e] = off - c; tb[MT_TST + e] = ts - nt;
            for (int r = 0; r < nt; ++r) tb[MT_TE + ts - nt + r] = e;
            if (e == NE - 1) { tb[MT_OFF + NE] = off; tb[MT_TST + NE] = ts; }
        }
    }
    LDS_WAIT();
    __syncthreads();
}
struct SchedMoe {
    int G, c, second, ibase; const LAS int* tb; const char* Ab; const char* Wb; const int* list; unsigned* tcnt; unsigned* tmo;
    __device__ __forceinline__ bool next(int i, Unit& u) const {
        const int ntl = tb[MT_TST + NE]; int L;
        if (!second) { L = c + i * G; if (L >= ntl * 4) return false; }
        else {
            const int n1 = ntl * 4, r = n1 % G, nl = G - r, lc = c - r;
            if (lc >= 0) L = (i < 2) ? lc + i * nl : 2 * nl + lc + (i - 2) * G; else L = 2 * nl + (nl + c) + i * G;
            if (L >= n1) return false; }
        const int ti = L >> 2; u.pn = L & 3; const int e = tb[MT_TE + ti]; const int r = ti - tb[MT_TST + e];
        u.pm = ti; u.aux = (e << 8) | r;
        if (!second) { u.A = Ab; u.B = Wb + (size_t)e * EXP_STRIDE + (size_t)u.pn * BM * D * 2; }
        else { u.A = Ab + (size_t)(tb[MT_OFF + e] + 256 * r) * DE * 2; u.B = Wb + (size_t)e * EXP_STRIDE + EXP_DN_OFF + (size_t)u.pn * BM * DE * 2; }
        return true;
    }
    __device__ __forceinline__ void a_ready(const Unit& u) const {
        if (!second) return;
        if (threadIdx.x < 64) {
            unsigned polls = 0;
            while ((unsigned)__builtin_amdgcn_readfirstlane(__hip_atomic_load(tcnt + 64 * u.pm, __ATOMIC_RELAXED, __HIP_MEMORY_SCOPE_AGENT)) < 32u) {
                __builtin_amdgcn_s_sleep(2);
                if ((++polls & 1023u) == 0u) { if (__builtin_amdgcn_readfirstlane(__hip_atomic_load(tmo, __ATOMIC_RELAXED, __HIP_MEMORY_SCOPE_AGENT)) != 0u) break;
                    if (polls > (1u << 22)) { if (threadIdx.x == 0) __hip_atomic_store(tmo, 1u, __ATOMIC_RELAXED, __HIP_MEMORY_SCOPE_AGENT); break; } }
            }
            __builtin_amdgcn_fence(__ATOMIC_ACQUIRE, "agent");
            asm volatile("s_waitcnt vmcnt(0)" ::: "memory");
        }
        asm volatile("" ::: "memory"); __builtin_amdgcn_s_barrier(); asm volatile("" ::: "memory");
    }
    __device__ __forceinline__ void lane_offs(const Unit& u, int tid, unsigned (&vo)[2][2]) const {
        if (!second) {
            const int e = u.aux >> 8, r = u.aux & 255; const int cn = tb[MT_CNT + e];
#pragma unroll
            for (int i = 0; i < 2; ++i) { int R, C; stage_rc(tid * 16 + i * 8192, R, C);
#pragma unroll
                for (int h = 0; h < 2; ++h) { const int row = 256 * r + 128 * h + R; const int tok = list[(size_t)e * T + (row < cn ? row : 0)]; vo[h][i] = (unsigned)(tok * D + C) * 2u; } }
        } else {
#pragma unroll
            for (int i = 0; i < 2; ++i) { int R, C; stage_rc(tid * 16 + i * 8192, R, C); vo[0][i] = (unsigned)(R * DE + C) * 2u; vo[1][i] = (unsigned)((R + HALF) * DE + C) * 2u; }
        }
    }
};
struct EpiMoe1 {
    static constexpr bool PERM = true;
    bf16* HID; const LAS int* tb; unsigned* tcnt;
    __device__ __forceinline__ void operator()(const f32x4 (&acc)[2][2][4][2], const Unit& u, int wr, int wc, int fr, int fq) const {
        const int e = u.aux >> 8, r = u.aux & 255; const int cn = tb[MT_CNT + e], off = tb[MT_OFF + e];
        const int col0 = u.pn * 128 + wc * 32 + 8 * fq;
        const __amdgpu_buffer_rsrc_t rsrc = __builtin_amdgcn_make_buffer_rsrc((void*)HID, 0, (int)((2 * T + 256) * DE * 2), 0x00020000);
#pragma unroll
        for (int ai = 0; ai < 2; ++ai)
#pragma unroll
            for (int m = 0; m < 4; ++m) { const int row = 256 * r + ai * HALF + wr * 64 + m * 16 + fr;
                float hv[8];
#pragma unroll
                for (int n = 0; n < 2; ++n)
#pragma unroll
                    for (int j = 0; j < 4; ++j) { const float g = acc[ai][0][m][n][j], up = acc[ai][1][m][n][j]; hv[4 * n + j] = g * sigm(g) * up; }
                u32x4 w; w.x = cvt_pk_bf16(hv[0], hv[1]); w.y = cvt_pk_bf16(hv[2], hv[3]); w.z = cvt_pk_bf16(hv[4], hv[5]); w.w = cvt_pk_bf16(hv[6], hv[7]);
                if (row < cn) __builtin_amdgcn_raw_buffer_store_b128(w, rsrc, (int)(((size_t)(off + row) * DE + col0) * 2), 0, 16); }
        asm volatile("s_waitcnt vmcnt(0)" ::: "memory");
        if ((threadIdx.x & 63) == 0) __hip_atomic_fetch_add(tcnt + 64 * u.pm, 1u, __ATOMIC_RELAXED, __HIP_MEMORY_SCOPE_AGENT);
    }
};
struct EpiMoe2 {
    static constexpr bool PERM = true;
    bf16* YB; const LAS int* tb;
    __device__ __forceinline__ void operator()(const f32x4 (&acc)[2][2][4][2], const Unit& u, int wr, int wc, int fr, int fq) const {
        const int e = u.aux >> 8, r = u.aux & 255; const int cn = tb[MT_CNT + e], off = tb[MT_OFF + e];
        const int col0 = u.pn * BM + wc * 32 + 8 * fq;
#pragma unroll
        for (int ai = 0; ai < 2; ++ai)
#pragma unroll
            for (int m = 0; m < 4; ++m) { const int row = 256 * r + ai * HALF + wr * 64 + m * 16 + fr;
                if (row < cn) {
#pragma unroll
                    for (int bj = 0; bj < 2; ++bj) { const f32x4 v0 = acc[ai][bj][m][0], v1 = acc[ai][bj][m][1];
                        u32x4 w; w.x = cvt_pk_bf16(v0[0], v0[1]); w.y = cvt_pk_bf16(v0[2], v0[3]); w.z = cvt_pk_bf16(v1[0], v1[1]); w.w = cvt_pk_bf16(v1[2], v1[3]);
                        *(GAS u32x4*)(YB + (size_t)(off + row) * D + col0 + bj * HALF) = w; } } }
    }
};
__device__ __forceinline__ void p6_phase(Frame& F, const Args& a) {
    const LAS int* tb = (const LAS int*)(F.lds + MOE_TAB_OFF);
    const int* tok_e = (const int*)(a.ws + WS_TOK + TOK_E); const float* tok_w = (const float*)(a.ws + WS_TOK + TOK_W); const int* tok_slot = (const int*)(a.ws + WS_TOK + TOK_SLOT);
    const bf16* YB = (const bf16*)(a.ws + WS_YB); float* out = a.out; const float* xin = a.in[0]; const bf16* TBp = (const bf16*)a.out;
    const int lane = F.lane, gw = F.vcu * NWAVES + F.wave, NGW = F.G * NWAVES;
    const int tmine = gw + NGW * (lane & 7);
    float mw1 = 0.f, mw2 = 0.f; unsigned mp1 = 0u, mp2 = 0u;
    if (tmine < T) { const int e1 = tok_e[2 * tmine], e2 = tok_e[2 * tmine + 1]; mw1 = tok_w[2 * tmine]; mw2 = tok_w[2 * tmine + 1];
        mp1 = (unsigned)(tb[MT_OFF + e1] + tok_slot[2 * tmine]); mp2 = (unsigned)(tb[MT_OFF + e2] + tok_slot[2 * tmine + 1]); }
    static_assert(T == 2048 * 8, "P6 assumes 8 tokens per wave on a 256 x 8 wave grid");
#pragma unroll 1
    for (int i0 = 0; i0 < 8; i0 += 4) {
        u32x2 tv[4][4], ya[4][4], yb[4][4]; float w1[4], w2[4];
#pragma unroll
        for (int i = 0; i < 4; ++i) { const int t = gw + NGW * (i0 + i); const size_t p1 = __shfl(mp1, i0 + i), p2 = __shfl(mp2, i0 + i); w1[i] = __shfl(mw1, i0 + i); w2[i] = __shfl(mw2, i0 + i);
#pragma unroll
            for (int j = 0; j < 4; ++j) { const int c = 4 * (lane + 64 * j);
                tv[i][j] = *(const GAS u32x2*)(TBp + (size_t)t * 2048 + c);
                ya[i][j] = *(const GAS u32x2*)(YB + p1 * D + c); yb[i][j] = *(const GAS u32x2*)(YB + p2 * D + c); } }
#pragma unroll
        for (int i = 0; i < 4; ++i) { const int t = gw + NGW * (i0 + i);
#pragma unroll
            for (int j = 0; j < 4; ++j) { const int c = 4 * (lane + 64 * j); f32x4 o;
                o[0] = bf_lo(tv[i][j].x) + w1[i] * bf_lo(ya[i][j].x) + w2[i] * bf_lo(yb[i][j].x); o[1] = bf_hi(tv[i][j].x) + w1[i] * bf_hi(ya[i][j].x) + w2[i] * bf_hi(yb[i][j].x);
                o[2] = bf_lo(tv[i][j].y) + w1[i] * bf_lo(ya[i][j].y) + w2[i] * bf_lo(yb[i][j].y); o[3] = bf_hi(tv[i][j].y) + w1[i] * bf_hi(ya[i][j].y) + w2[i] * bf_hi(yb[i][j].y);
                if (t < T && !a.dry) *(GAS f32x4*)(out + (size_t)t * D + c) = o; else asm volatile("" :: "v"(o)); } }
    }
}

__global__ void __launch_bounds__(NWAVES * 64, 2) fwd(Args args) {
    extern __shared__ __attribute__((aligned(16))) unsigned char lds[];
    Frame F;
    F.lds = (LAS unsigned char*)lds;
    F.MISC = (volatile LAS unsigned*)(F.lds + MISC_OFF);
    F.tid = threadIdx.x; F.lane = F.tid & 63; F.wave = __builtin_amdgcn_readfirstlane(F.tid >> 6);
    F.G = gridDim.x; { const int bx = blockIdx.x; F.vcu = (F.G % 8 == 0) ? (bx % 8) * (F.G / 8) + bx / 8 : bx; }
    unsigned char* ws = args.ws;
    F.ctl = (gu32*)(ws + WS_CTL);
    for (int u = F.tid; u < (LDS_BYTES - LDSCTL_OFF) / 4; u += NWAVES * 64) ((LAS unsigned*)(F.lds + LDSCTL_OFF))[u] = 0u;
    __syncthreads();
    const int lo = args.ph_lo, hi = args.ph_hi;
    XcdBarrier bar; bar.bar = (unsigned*)(F.ctl + CW_BAR) + args.li * XCD_BAR_WORDS; bar.x = 0; bar.st = nullptr;
    if (hi - lo > 1) bar = xcd_barrier_post((unsigned*)(F.ctl + CW_BAR) + args.li * XCD_BAR_WORDS, F.MISC + 8);
#define IN(k) (lo <= (k) && (k) < hi)
#define SEAM_CUT(k) do { } while (0)
#define SEAM(k) do { if (IN(k) && (IN((k) + 1) || ((k) == 8 && IN(10)) || ((k) == 3 && IN(5)))) xcd_barrier(bar); } while (0)

    if (IN(0)) { p0_prologue(F, args); }
    SEAM(0);
    if (IN(1)) {
        SchedP1 S{F.G, (int)blockIdx.x, (const char*)(ws + WS_D), (const char*)(ws + WS_WIN_T)};
        EpiP1 E{(bf16*)(ws + WS_E), (bf16*)args.out, (float*)(ws + WS_GM), args.in[13], args.in[9]};
        const bool early = ((blockIdx.x >> 3) & 1) == 0;
        const int grank = (int)(blockIdx.x >> 4) * 8 + (int)(blockIdx.x & 7);
        if (early) { p0_experts(F, args, 0, MK_EXP_SPLIT_A, grank, 128); p0_experts(F, args, 12288, EXP_ITEMS, grank, 128); }
        gemm_phase<EpiP1, SchedP1>(F.lds, D, S, E);
        if (!early) p0_experts(F, args, MK_EXP_SPLIT_A, MK_EXP_SPLIT_B, grank, 128);
    }
    SEAM(1);
#if MK_NPH > 2
    if (IN(2)) { p2a_phase(F, args); }
    SEAM(2);
#endif
#if MK_NPH > 3
    if (IN(3)) { p2m_phase(F, args); }
    SEAM(3);
#endif
#if MK_NPH > 5
    if (IN(5)) {
        unsigned* pcnt = (unsigned*)(F.ctl + CW_PAN);
        {
            int pm, pn; tile_order(0, F.G, (int)blockIdx.x, T / BM, D / BM, pm, pn);
            if ((pm & 1) && MK_EXP_SPLIT_B < MK_EXP_SPLIT_C && !args.dry) p0_experts(F, args, MK_EXP_SPLIT_B, MK_EXP_SPLIT_C, (pm >> 1) * 4 + pn, 128);
        }
        if (!args.dry) { int pm, pn; if (tile_order(0, F.G, (int)blockIdx.x, T / BM, D / BM, pm, pn)) p2b_rows(F, args, pm * BM + pn * 64, pcnt + 64 * pm); }
        SchedP3a S{F.G, (int)blockIdx.x, (const char*)(ws + WS_E), (const char*)(ws + WS_WA_T), (const char*)(ws + WS_WM_T), (const char*)(ws + WS_YA), pcnt, (unsigned*)(F.ctl + CW_TMO)};
        EpiP3a E{(bf16*)(ws + WS_D), (const bf16*)args.out, (unsigned*)(F.ctl + CW_PANU)};
        gemm_phase<EpiP3a, SchedP3a>(F.lds, 512, S, E);
    }
    SEAM_CUT(5);
    if (IN(6)) {
        {
            int pm, pn; tile_order(0, F.G, (int)blockIdx.x, T / BM, D / BM, pm, pn);
            if (!(pm & 1) && MK_EXP_SPLIT_C < MK_EXP_SPLIT_D) p0_experts(F, args, MK_EXP_SPLIT_C, MK_EXP_SPLIT_D, (pm >> 1) * 4 + pn, 128);
        }
        SchedP3b S{F.G, (int)blockIdx.x, (const char*)(ws + WS_D), (const char*)(ws + WS_WOUT_T), (unsigned*)(F.ctl + CW_PANU), (unsigned*)(F.ctl + CW_TMO)};
        EpiP3b E{(bf16*)args.out, (unsigned*)(F.ctl + CW_PANT)};
        gemm_phase<EpiP3b, SchedP3b>(F.lds, D, S, E);
    }
    SEAM_CUT(6);
#endif
#if MK_NPH > 7
    if (IN(7)) {
        {
            int pm, pn; tile_order(0, F.G, (int)blockIdx.x, T / BM, D / BM, pm, pn);
            if ((pm & 1) && MK_EXP_SPLIT_D < 12288 && !args.dry) p0_experts(F, args, MK_EXP_SPLIT_D, 12288, (pm >> 1) * 4 + pn, 128);
        }
        p4_phase(F, args); }
    SEAM(7);
    if (IN(8)) {
        moe_tables(F);
        const LAS int* tb = (const LAS int*)(F.lds + MOE_TAB_OFF);
        unsigned* tcnt = (unsigned*)(F.ctl + CW_TILE); unsigned* tmo = (unsigned*)(F.ctl + CW_TMO);
        const int n1 = tb[MT_TST + NE] * 4; const int i1 = (F.vcu < n1) ? (n1 - F.vcu + F.G - 1) / F.G : 0;
        {   SchedMoe S{F.G, F.vcu, 0, 0, tb, (const char*)(ws + WS_D), (const char*)(ws + WS_EXP), (const int*)(ws + WS_TOK + TOK_LIST), tcnt, tmo};
            EpiMoe1 E{(bf16*)(ws + WS_HID), tb, tcnt};
            gemm_phase<EpiMoe1, SchedMoe>(F.lds, D, S, E); }
        {   SchedMoe S{F.G, F.vcu, 1, i1, tb, (const char*)(ws + WS_HID), (const char*)(ws + WS_EXP), (const int*)(ws + WS_TOK + TOK_LIST), tcnt, tmo};
            EpiMoe2 E{(bf16*)(ws + WS_YB), tb};
            gemm_phase<EpiMoe2, SchedMoe>(F.lds, DE, S, E); }
    }
    SEAM(8);
    if (IN(10)) { moe_tables(F); p6_phase(F, args); }
#endif
#undef IN
#undef SEAM
}
}

extern "C" void kernel_launch(void* const* d_in, const int* in_sizes, int n_in, void* d_out, int out_size, void* d_ws, size_t ws_size, hipStream_t stream) {
    static int grid = 0;
    if (grid == 0) {
        int dev = 0, cus = 0;
        if (n_in != 23 || out_size != mk::T * mk::D || ws_size < mk::WS_END) { fprintf(stderr, "kernel_launch: unexpected problem (n_in %d, out %d, ws %zu < %zu)\n", n_in, out_size, ws_size, (size_t)mk::WS_END); grid = -1; return; }
        if (hipGetDevice(&dev) != hipSuccess || hipDeviceGetAttribute(&cus, hipDeviceAttributeMultiprocessorCount, dev) != hipSuccess) { grid = -1; return; }
        if (hipFuncSetAttribute((const void*)mk::fwd, hipFuncAttributeMaxDynamicSharedMemorySize, mk::LDS_BYTES) != hipSuccess) { fprintf(stderr, "kernel_launch: hipFuncSetAttribute failed\n"); grid = -1; return; }
        int per_cu = 0;
        if (hipOccupancyMaxActiveBlocksPerMultiprocessor(&per_cu, (const void*)mk::fwd, mk::NWAVES * 64, mk::LDS_BYTES) != hipSuccess || per_cu < 1) { fprintf(stderr, "kernel_launch: occupancy query reports %d workgroups per CU\n", per_cu); }
        (void)hipGetLastError();
        grid = cus;
        if (grid != 256) { fprintf(stderr, "kernel_launch: built for a 256-CU device (one 256x256 merge/out-GEMM tile and 64 router rows per workgroup); found %d CUs; nothing launched\n", grid); grid = -1; return; }
    }
    if (grid < 0) return;
    (void)hipMemsetAsync((char*)d_ws + mk::WS_CTL, 0, mk::CTL_ZERO_BYTES, stream);
    mk::Args a{};
    for (int i = 0; i < 23; ++i) a.in[i] = (const float*)d_in[i];
    a.out = (float*)d_out; a.ws = (unsigned char*)d_ws;
    const int launches[][3] = {MK_LAUNCHES};
    for (int li = 0; li < (int)(sizeof(launches) / sizeof(launches[0])); ++li) {
        a.ph_lo = launches[li][0]; a.ph_hi = launches[li][1]; a.li = li; a.dry = launches[li][2];
        hipLaunchKernelGGL(mk::fwd, dim3(grid), dim3(mk::NWAVES * 64), mk::LDS_BYTES, stream, a);
    }
}
```

```cpp
#include <hip/hip_runtime.h>
#include <stdio.h>
#include <math.h>
#define MK_LAUNCHES {0,11,0}
#define MK_NPH 11

namespace mk {
#define LAS __attribute__((address_space(3)))
#define GAS __attribute__((address_space(1)))
typedef unsigned short bf16;
typedef short bf16x8 __attribute__((ext_vector_type(8)));
typedef short s16x4 __attribute__((ext_vector_type(4)));
typedef float f32x4 __attribute__((ext_vector_type(4)));
typedef float f32x2 __attribute__((ext_vector_type(2)));
typedef float f32x16 __attribute__((ext_vector_type(16)));
typedef unsigned u32x4 __attribute__((ext_vector_type(4)));
typedef unsigned u32x2 __attribute__((ext_vector_type(2)));
typedef GAS unsigned gu32;

constexpr int Bz = 8, S = 2048, D = 1024, T = Bz * S;
constexpr int NPAD = 5120;
constexpr int PA_LD = 2816;
constexpr int PC_QA = 0, PC_KA = 512, PC_VA = 640, PC_QM = 768, PC_KM = 1280, PC_VM = 1792, PC_OM = 2304;
constexpr int NE = 32, DE = 512;
constexpr int NWAVES = 8;

constexpr size_t MiB = (size_t)1 << 20;
constexpr size_t WS_CTL = 0, CTL_ZERO_BYTES = 1 * MiB;
constexpr size_t WS_WIN_T = 1 * MiB;
constexpr size_t WS_WA_T = 11 * MiB;
constexpr size_t WS_WM_T = 12 * MiB;
constexpr size_t WS_WOUT_T = 13 * MiB;
constexpr size_t WS_GM = 15 * MiB;
constexpr size_t WS_TOK = 16 * MiB;
constexpr size_t WS_EXP = 20 * MiB;
constexpr size_t EXP_STRIDE = 3 * MiB, EXP_DN_OFF = 2 * MiB;
constexpr size_t WS_D = 116 * MiB;
constexpr size_t WS_E = 148 * MiB;
constexpr size_t WS_YA = 246 * MiB; constexpr size_t WS_END = 262 * MiB;
constexpr int CW_TMO = 0, CW_CODE = 1;
constexpr int CW_CNT = 64;
constexpr int CW_BAR = 4096;
constexpr int CW_PAN = 32768;
constexpr int CW_CONV = 45056;
constexpr int CW_PANU = 36864, CW_PANT = 40960;
constexpr int CW_TILE = 65536;
constexpr int RING_BYTES = 131072;
constexpr int LDS_BYTES = 163840;
constexpr int LDSCTL_OFF = LDS_BYTES - 4096, MISC_OFF = LDSCTL_OFF;
constexpr int MOE_TAB_OFF = LDSCTL_OFF + 256;

#define LDS_WAIT() asm volatile("s_waitcnt lgkmcnt(0)" ::: "memory")
#define VM_WAIT() asm volatile("s_waitcnt vmcnt(0)" ::: "memory")
__device__ __forceinline__ unsigned f2bf(float f) { unsigned u = __builtin_bit_cast(unsigned, f); return (u + 0x7fffu + ((u >> 16) & 1u)) >> 16; }

__device__ __forceinline__ float bf_lo(unsigned w) { return __builtin_bit_cast(float, w << 16); }
__device__ __forceinline__ float bf_hi(unsigned w) { return __builtin_bit_cast(float, w & 0xffff0000u); }
typedef __bf16 bf16x2_t __attribute__((ext_vector_type(2)));
__device__ __forceinline__ unsigned cvt_pk_bf16(float lo, float hi) { f32x2 v = {lo, hi}; bf16x2_t b = __builtin_convertvector(v, bf16x2_t); return __builtin_bit_cast(unsigned, b); }
__device__ __forceinline__ unsigned pk2(float lo, float hi) { return cvt_pk_bf16(lo, hi); }
__device__ __forceinline__ float sigm(float x) { return __builtin_amdgcn_rcpf(1.f + __builtin_amdgcn_exp2f(-1.4426950408889634f * x)); }
#define DPP_ADD(v, ctrl, rm) ((v) + __builtin_bit_cast(float, __builtin_amdgcn_update_dpp(0, __builtin_bit_cast(int, (v)), (ctrl), (rm), 0xF, true)))
__device__ __forceinline__ float wave_sum(float v) {
    v = DPP_ADD(v, 0xB1, 0xF);
    v = DPP_ADD(v, 0x4E, 0xF);
    v = DPP_ADD(v, 0x141, 0xF);
    v = DPP_ADD(v, 0x140, 0xF);
    v = DPP_ADD(v, 0x142, 0xA);
    v = DPP_ADD(v, 0x143, 0xC);
    return __builtin_bit_cast(float, __builtin_amdgcn_readlane(__builtin_bit_cast(int, v), 63));
}

#define XB_TMO      128
#define XB_XCNT(j)  (256  + 64 * (j))
#define XB_XSUB(j)  (1280 + 64 * (j))
#define XB_XGEN(j)  (2304 + 64 * (j))
#define XB_TOP      3328
#define XB_TOPGEN   3392
#define XCD_BAR_WORDS 3456
#define XB_SPIN_CAP (1u << 18)
__device__ __forceinline__ unsigned xb_ld(unsigned* p)              { return __hip_atomic_load(p, __ATOMIC_RELAXED, __HIP_MEMORY_SCOPE_AGENT); }
__device__ __forceinline__ unsigned xb_add(unsigned* p, unsigned v) { return __hip_atomic_fetch_add(p, v, __ATOMIC_RELAXED, __HIP_MEMORY_SCOPE_AGENT); }
__device__ __forceinline__ unsigned xb_xcc_id() { return (unsigned)__builtin_amdgcn_s_getreg((3 << 11) | 20) & 0xFu; }
#define XB_SPIN(cond, bar) do { unsigned _sp = 0; while (cond) { __builtin_amdgcn_s_sleep(1); \
    if ((++_sp & 255u) == 0u) { if (xb_ld(&(bar)[XB_TMO])) break; if (_sp > XB_SPIN_CAP) { atomicAdd(&(bar)[XB_TMO], 1u); break; } } } } while (0)
struct XcdBarrier { unsigned* bar; unsigned x; volatile LAS unsigned* st; };
__device__ __forceinline__ XcdBarrier xcd_barrier_post(unsigned* bar, volatile LAS unsigned* st) {
    XcdBarrier b; b.bar = bar; b.x = xb_xcc_id(); b.st = st;
    if (threadIdx.x == 0) (void)xb_add(&bar[XB_XCNT(b.x)], 1u);
    return b;
}
__device__ __forceinline__ void xcd_barrier_complete(unsigned* bar, unsigned x, unsigned& nloc, unsigned& nx) {
    const unsigned G = gridDim.x * gridDim.y * gridDim.z;
    unsigned sum, cnt, mine, sp = 0u;
    for (;;) {
        sum = 0u; cnt = 0u; mine = 0u;
#pragma unroll
        for (unsigned j = 0; j < 16; ++j) { const unsigned c = xb_ld(&bar[XB_XCNT(j)]); sum += c; cnt += (c > 0u) ? 1u : 0u; mine = (j == x) ? c : mine; }
        if (sum == G) break;
        __builtin_amdgcn_s_sleep(1);
        if ((++sp & 255u) == 0u) { if (xb_ld(&bar[XB_TMO])) break; if (sp > XB_SPIN_CAP) { atomicAdd(&bar[XB_TMO], 1u); break; } }
    }
    nloc = mine > 0u ? mine : 1u; nx = cnt > 0u ? cnt : 1u;
}
__device__ __forceinline__ void xcd_barrier(const XcdBarrier& b) {
    asm volatile("s_waitcnt vmcnt(0)" ::: "memory");
    __syncthreads();
    if (threadIdx.x == 0) {
        unsigned* bar = b.bar;
        __builtin_amdgcn_s_waitcnt(0);
        unsigned nloc = b.st[0], nx = b.st[1];
        if (nloc == 0u) { xcd_barrier_complete(bar, b.x, nloc, nx); b.st[0] = nloc; b.st[1] = nx; }
        const unsigned old = xb_add(&bar[XB_XSUB(b.x)], 1u);
        const unsigned gen = old / nloc;
        if (old + 1u == (gen + 1u) * nloc) {
            __builtin_amdgcn_fence(__ATOMIC_RELEASE, "agent");
            asm volatile("s_waitcnt vmcnt(0)" ::: "memory");
            const unsigned og = xb_add(&bar[XB_TOP], 1u);
            const unsigned tg = og / nx;
            if (og + 1u == (tg + 1u) * nx) xb_add(&bar[XB_TOPGEN], 1u);
            else XB_SPIN(xb_ld(&bar[XB_TOPGEN]) == tg, bar);
            __builtin_amdgcn_fence(__ATOMIC_ACQUIRE, "agent");
            xb_add(&bar[XB_XGEN(b.x)], 1u);
            asm volatile("s_waitcnt vmcnt(0)" ::: "memory");
        } else {
            XB_SPIN(xb_ld(&bar[XB_XGEN(b.x)]) == gen, bar);
            __builtin_amdgcn_fence(__ATOMIC_ACQUIRE, "agent");
            asm volatile("s_waitcnt vmcnt(0)" ::: "memory");
        }
    }
    __syncthreads();
}


__device__ __forceinline__ void panel_wait(unsigned* cnt, unsigned need, unsigned* tmo) {
    if (threadIdx.x < 64) {
        unsigned polls = 0;
        while ((unsigned)__builtin_amdgcn_readfirstlane(__hip_atomic_load(cnt, __ATOMIC_RELAXED, __HIP_MEMORY_SCOPE_AGENT)) < need) {
            __builtin_amdgcn_s_sleep(2);
            if ((++polls & 1023u) == 0u) { if (__builtin_amdgcn_readfirstlane(__hip_atomic_load(tmo, __ATOMIC_RELAXED, __HIP_MEMORY_SCOPE_AGENT)) != 0u) break;
                if (polls > (1u << 22)) { if (threadIdx.x == 0) __hip_atomic_store(tmo, 1u, __ATOMIC_RELAXED, __HIP_MEMORY_SCOPE_AGENT); break; } }
        }
        __builtin_amdgcn_fence(__ATOMIC_ACQUIRE, "agent");
        asm volatile("s_waitcnt vmcnt(0)" ::: "memory");
    }
    asm volatile("" ::: "memory"); __builtin_amdgcn_s_barrier(); asm volatile("" ::: "memory");
}

constexpr int BM = 256, BK = 64, HALF = 128, HTB = HALF * BK * 2, STAGE_BYTES = 8 * HTB, NXCD = 8, WGM = 8;
__host__ __device__ __forceinline__ int lds_byte(int r, int c) { const int st = (r >> 4) * 2 + (c >> 5), rr = r & 15, cc = c & 31, ob = rr * 64 + cc * 2; return st * 1024 + (ob ^ (((ob >> 9) & 1) << 5)); }
__host__ __device__ __forceinline__ void stage_rc(int b, int& R, int& C) { const int st = b / 1024, sb = b % 1024, swz = sb ^ (((sb >> 9) & 1) << 5); R = (st >> 1) * 16 + swz / 64; C = (st & 1) * 32 + (swz % 64) / 2; }
__host__ __device__ __forceinline__ int perm32(int rho) { const int n = rho >> 4, i = rho & 15; return 8 * (i >> 2) + 4 * n + (i & 3); }

struct Unit { int pm, pn, aux; const char* A; const char* B; };
__device__ __forceinline__ bool tile_order(int i, int G, int c, int nM, int nN, int& pm, int& pn) {
    const int nwg = nM * nN; const long L = (long)i * G + c; if (L >= nwg) return false;
    int wgid = (int)L; { const int q = nwg / NXCD, r = nwg % NXCD, xcd = wgid % NXCD, off = wgid / NXCD; wgid = (xcd < r ? xcd * (q + 1) : r * (q + 1) + (xcd - r) * q) + off; }
    const int nig = WGM * nN, gid = wgid / nig, fm = gid * WGM, gsz = (nM - fm) < WGM ? (nM - fm) : WGM;
    pm = fm + ((wgid % nig) % gsz); pn = (wgid % nig) / gsz; return true;
}

template <class Epi, class Sched>
__device__ __forceinline__ void gemm_phase(LAS unsigned char* lds, const int K, const Sched& S, const Epi& E) {
    const int tid = threadIdx.x, wid = __builtin_amdgcn_readfirstlane(tid >> 6), lane = tid & 63, wr = wid >> 2, wc = wid & 3, fr = lane & 15, fq = lane >> 4;
    const int nt = K / BK;
    unsigned voffB[2];
#pragma unroll
    for (int i = 0; i < 2; ++i) { int R, C; stage_rc(tid * 16 + i * 8192, R, C); const int Rb = Epi::PERM ? ((R & ~31) + perm32(R & 31)) : R; voffB[i] = (unsigned)(Rb * K + C) * 2u; }
    const size_t kstep = (size_t)(BK * 2);
    const size_t hstepB = (size_t)HALF * K * 2;
    const unsigned ldsw = (unsigned)wid * 1024u;
    const int aoff = lds_byte(wr * 64 + fr, fq * 8), boff = lds_byte(wc * 32 + fr, fq * 8);
#define PG8_SA(b, h) (((b) * 2 + (h)) * HTB)
#define PG8_SB(b, h) ((4 + (b) * 2 + (h)) * HTB)
#define PG8_STAGE(bufoff, gbase, voff) do { _Pragma("unroll") for (int _i = 0; _i < 2; ++_i) \
        __builtin_amdgcn_global_load_lds((const unsigned*)((const char*)(gbase) + (voff)[_i]), (LAS unsigned*)(lds + (bufoff) + ldsw + _i * 8192), 16, 0, 0); } while (0)
#define PG8_LDA(dst, b, h) do { _Pragma("unroll") for (int m = 0; m < 4; ++m) _Pragma("unroll") for (int k = 0; k < 2; ++k) dst[m][k] = *(const LAS bf16x8*)(lds + PG8_SA(b, h) + aoff + m * 2048 + k * 1024); } while (0)
#define PG8_LDB(dst, b, h) do { _Pragma("unroll") for (int n = 0; n < 2; ++n) _Pragma("unroll") for (int k = 0; k < 2; ++k) dst[n][k] = *(const LAS bf16x8*)(lds + PG8_SB(b, h) + boff + n * 2048 + k * 1024); } while (0)
#define PG8_MMA(ai, bj, At, Bt) do { __builtin_amdgcn_s_setprio(1); _Pragma("unroll") for (int m = 0; m < 4; ++m) _Pragma("unroll") for (int n = 0; n < 2; ++n) _Pragma("unroll") for (int k = 0; k < 2; ++k) \
        acc[ai][bj][m][n] = __builtin_amdgcn_mfma_f32_16x16x32_bf16(Bt[n][k], At[m][k], acc[ai][bj][m][n], 0, 0, 0); __builtin_amdgcn_s_setprio(0); } while (0)
#define PG8_WAIT_V(n) asm volatile("s_waitcnt vmcnt(" #n ")" ::: "memory")
#define PG8_WAIT_L(n) asm volatile("s_waitcnt lgkmcnt(" #n ")" ::: "memory")
#define PG8_BAR __builtin_amdgcn_s_barrier()
#define PG8_SCHED __builtin_amdgcn_sched_barrier(0)
    Unit cur, nxt; int ui = 0;
    if (!S.next(0, cur)) return;
    f32x4 acc[2][2][4][2];
#pragma unroll
    for (int a = 0; a < 2; ++a)
#pragma unroll
        for (int b = 0; b < 2; ++b)
#pragma unroll
            for (int m = 0; m < 4; ++m)
#pragma unroll
                for (int n = 0; n < 2; ++n) acc[a][b][m][n] = (f32x4){0.f, 0.f, 0.f, 0.f};
    bf16x8 At[4][2], B0[2][2], B1[2][2];
    unsigned voC[2][2], voN[2][2];
    S.a_ready(cur);
    S.lane_offs(cur, tid, voC);
    const char* cA = cur.A; const char* cB = cur.B;
    PG8_STAGE(PG8_SB(0, 0), cB, voffB); PG8_STAGE(PG8_SB(0, 1), cB + hstepB, voffB); PG8_STAGE(PG8_SA(0, 0), cA, voC[0]); PG8_STAGE(PG8_SA(0, 1), cA, voC[1]);
    if (wr == 1) PG8_BAR;
    PG8_WAIT_V(2); PG8_BAR;
    PG8_STAGE(PG8_SB(1, 0), cB + kstep, voffB); PG8_STAGE(PG8_SA(1, 0), cA + kstep, voC[0]); PG8_STAGE(PG8_SB(1, 1), cB + hstepB + kstep, voffB);
    PG8_WAIT_V(6); PG8_BAR;
    for (;;) {
        const bool has_next = S.next(ui + 1, nxt);
        const char* nA = has_next ? nxt.A : cA; const char* nB = has_next ? nxt.B : cB;
        if (has_next) S.lane_offs(nxt, tid, voN);
        else { voN[0][0] = voC[0][0]; voN[0][1] = voC[0][1]; voN[1][0] = voC[1][0]; voN[1][1] = voC[1][1]; }
        for (int t = 0; t < nt; t += 2) {
            const bool last = (t == nt - 2);
            if (last && has_next) S.a_ready(nxt);
            const char* a1 = cA + (size_t)(t + 1) * kstep;
            const char* a2 = last ? nA : cA + (size_t)(t + 2) * kstep; const char* b2 = last ? nB : cB + (size_t)(t + 2) * kstep;
            const char* a3 = a2 + kstep; const char* b3 = b2 + kstep;
            unsigned v20[2], v21[2];
            v20[0] = last ? voN[0][0] : voC[0][0]; v20[1] = last ? voN[0][1] : voC[0][1]; v21[0] = last ? voN[1][0] : voC[1][0]; v21[1] = last ? voN[1][1] : voC[1][1];
            PG8_LDB(B0, 0, 0); PG8_LDB(B1, 0, 1); PG8_SCHED; PG8_LDA(At, 0, 0); PG8_STAGE(PG8_SA(1, 1), a1, voC[1]);
            PG8_WAIT_V(8); PG8_WAIT_L(0); PG8_BAR; PG8_MMA(0, 0, At, B0); PG8_MMA(0, 1, At, B1); PG8_BAR; PG8_SCHED;
            PG8_LDA(At, 0, 1); PG8_STAGE(PG8_SB(0, 0), b2, voffB); PG8_STAGE(PG8_SB(0, 1), b2 + hstepB, voffB); PG8_STAGE(PG8_SA(0, 0), a2, v20);
            PG8_WAIT_V(8); PG8_WAIT_L(0); PG8_BAR; PG8_MMA(1, 0, At, B0); PG8_MMA(1, 1, At, B1); PG8_BAR; PG8_SCHED;
            PG8_LDB(B0, 1, 0); PG8_LDB(B1, 1, 1); PG8_SCHED; PG8_LDA(At, 1, 0); PG8_STAGE(PG8_SA(0, 1), a2, v21);
            PG8_WAIT_V(8); PG8_WAIT_L(0); PG8_BAR; PG8_MMA(0, 0, At, B0); PG8_MMA(0, 1, At, B1); PG8_BAR; PG8_SCHED;
            PG8_LDA(At, 1, 1); PG8_STAGE(PG8_SB(1, 0), b3, voffB); PG8_STAGE(PG8_SB(1, 1), b3 + hstepB, voffB); PG8_STAGE(PG8_SA(1, 0), a3, v20);
            PG8_WAIT_V(8); PG8_WAIT_L(0); PG8_BAR; PG8_MMA(1, 0, At, B0); PG8_MMA(1, 1, At, B1); PG8_BAR; PG8_SCHED;
        }
        if (wr == 0) PG8_BAR;
        E(acc, cur, wr, wc, fr, fq);
        if (!has_next) break;
#pragma unroll
        for (int a = 0; a < 2; ++a)
#pragma unroll
            for (int b = 0; b < 2; ++b)
#pragma unroll
                for (int m = 0; m < 4; ++m)
#pragma unroll
                    for (int n = 0; n < 2; ++n) acc[a][b][m][n] = (f32x4){0.f, 0.f, 0.f, 0.f};
        cur = nxt; cA = nA; cB = nB; ++ui;
        voC[0][0] = voN[0][0]; voC[0][1] = voN[0][1]; voC[1][0] = voN[1][0]; voC[1][1] = voN[1][1];
        if (wr == 1) PG8_BAR;
    }
    PG8_WAIT_V(0);
    PG8_BAR;
#undef PG8_SA
#undef PG8_SB
#undef PG8_STAGE
#undef PG8_LDA
#undef PG8_LDB
#undef PG8_MMA
#undef PG8_WAIT_V
#undef PG8_WAIT_L
#undef PG8_BAR
#undef PG8_SCHED
}

struct Args { const float* in[23]; float* out; unsigned char* ws; int ph_lo, ph_hi, li, dry; };
struct Frame {
    LAS unsigned char* lds; volatile LAS unsigned* MISC; gu32* ctl;
    int tid, lane, wave, vcu, G;
};
#ifdef MK_TL_SEL
#define MK_TS(F, i) do { if (blockIdx.x == MK_TL_WG && (F).tid == 0) { __builtin_amdgcn_sched_barrier(0); const unsigned long long t_ = __builtin_amdgcn_s_memrealtime(); asm volatile("s_waitcnt lgkmcnt(0)" ::: "memory"); ((volatile LAS unsigned*)((F).lds + LDSCTL_OFF + 3200))[i] = (unsigned)t_; __builtin_amdgcn_sched_barrier(0); } } while (0)
#else
#define MK_TS(F, i) do { } while (0)
#endif

constexpr int TP_PITCH = 136;
template <class SCol, class DRow>
__device__ __forceinline__ void p0_transpose_item(const float* W, int K, int N, int nblk, bf16* WT, LAS unsigned char* scr, int item, int lane, SCol scol, DRow drow) {
    const int kb = item / nblk, nb = item - kb * nblk, k0 = 64 * kb, n0 = 64 * nb;
    const int kr = lane >> 4, n4 = lane & 15;
    const int sc = scol(n0 + 4 * n4);
    f32x4 v[8][2];
#pragma unroll
    for (int i = 0; i < 8; ++i)
#pragma unroll
        for (int pp = 0; pp < 2; ++pp) v[i][pp] = (sc >= 0) ? *(const GAS f32x4*)(W + (size_t)(k0 + 8 * i + 2 * kr + pp) * N + sc) : (f32x4){0.f, 0.f, 0.f, 0.f};
#pragma unroll
    for (int i = 0; i < 8; ++i)
#pragma unroll
        for (int j = 0; j < 4; ++j) *(LAS unsigned*)(scr + (4 * n4 + j) * TP_PITCH + (4 * i + kr) * 4) = cvt_pk_bf16(v[i][0][j], v[i][1][j]);
    LDS_WAIT(); asm volatile("" ::: "memory");
#pragma unroll
    for (int i = 0; i < 8; ++i) { const int nr = 8 * i + (lane >> 3), pc = lane & 7;
        const u32x2 a = *(const LAS u32x2*)(scr + nr * TP_PITCH + pc * 16), b = *(const LAS u32x2*)(scr + nr * TP_PITCH + pc * 16 + 8);
        *(GAS u32x4*)(WT + (size_t)drow(n0 + nr) * K + k0 + 8 * pc) = (u32x4){a.x, a.y, b.x, b.y}; }
    LDS_WAIT(); asm volatile("" ::: "memory");
}
__device__ __forceinline__ int win_src_col(int n) { return n < 2816 ? n : (n < 4864 ? n + 16 : (n < 4880 ? n - 2048 : -1)); }

__device__ __forceinline__ void p0_prologue(Frame& F, const Args& a) {
    LAS unsigned char* scr = F.lds + F.wave * 16384;
    const int gw = F.vcu * NWAVES + F.wave, NGW = F.G * NWAVES;
    unsigned char* ws = a.ws;
    const float* w_in = a.in[2];
    constexpr int I_IN = (D / 64) * (NPAD / 64);
    for (int it = gw; it < I_IN; it += NGW)
        p0_transpose_item(w_in, D, 4880, NPAD / 64, (bf16*)(ws + WS_WIN_T), scr, it, F.lane, [](int n) { return win_src_col(n); }, [](int n) { return n; });
    const float* x = a.in[0]; const float* g1 = a.in[1]; bf16* XN = (bf16*)(ws + WS_D);
    f32x4 gv[4];
#pragma unroll
    for (int j = 0; j < 4; ++j) gv[j] = ((const GAS f32x4*)g1)[F.lane + 64 * j];
    for (int m = gw; m < T; m += NGW) {
        const GAS f32x4* xr = (const GAS f32x4*)(x + (size_t)m * D) + F.lane;
        f32x4 v[4]; float s = 0.f;
#pragma unroll
        for (int j = 0; j < 4; ++j) { v[j] = xr[64 * j]; s += (v[j].x * v[j].x + v[j].y * v[j].y) + (v[j].z * v[j].z + v[j].w * v[j].w); }
        const float rstd = rsqrtf(wave_sum(s) * (1.f / D) + 1e-6f);
        GAS unsigned long long* o8 = (GAS unsigned long long*)(XN + (size_t)m * D) + F.lane;
#pragma unroll
        for (int j = 0; j < 4; ++j) { const f32x4 y = v[j] * rstd * gv[j]; o8[64 * j] = (unsigned long long)pk2(y.x, y.y) | ((unsigned long long)pk2(y.z, y.w) << 32); }
    }
}

__device__ __forceinline__ void p0_experts(Frame& F, const Args& a, int item_lo, int item_hi, int rank, int nranks) {
    LAS unsigned char* scr = F.lds + F.wave * 16384;
    unsigned char* ws = a.ws;
    const float* w_g = a.in[20]; const float* w_u = a.in[21]; const float* w_d = a.in[22];
    constexpr int I_G = (D / 64) * (DE / 64), I_D = (DE / 64) * (D / 64), I_EXP = 2 * I_G + I_D;
    constexpr int I_A = (512 / 64) * (D / 64), I_OUT = (D / 64) * (D / 64);
    for (int it = item_lo + rank * NWAVES + F.wave; it < item_hi; it += nranks * NWAVES) {
        if (it >= NE * I_EXP) {
            int r2 = it - NE * I_EXP;
            if (r2 < I_A) { p0_transpose_item(a.in[11], 512, D, D / 64, (bf16*)(ws + WS_WA_T), scr, r2, F.lane, [](int n) { return n; }, [](int n) { return n; }); continue; } r2 -= I_A;
            if (r2 < I_A) { p0_transpose_item(a.in[12], 512, D, D / 64, (bf16*)(ws + WS_WM_T), scr, r2, F.lane, [](int n) { return n; }, [](int n) { return n; }); continue; } r2 -= I_A;
            p0_transpose_item(a.in[14], D, D, D / 64, (bf16*)(ws + WS_WOUT_T), scr, r2, F.lane, [](int n) { return n; }, [](int n) { return n; }); continue;
        }
        const int e = it / I_EXP; int r = it - e * I_EXP;
        bf16* gu = (bf16*)(ws + WS_EXP + (size_t)e * EXP_STRIDE); bf16* dn = (bf16*)(ws + WS_EXP + (size_t)e * EXP_STRIDE + EXP_DN_OFF);
        if (r < I_G) { p0_transpose_item(w_g + (size_t)e * D * DE, D, DE, DE / 64, gu, scr, r, F.lane, [](int n) { return n; }, [](int n) { return 256 * (n >> 7) + (n & 127); }); continue; } r -= I_G;
        if (r < I_G) { p0_transpose_item(w_u + (size_t)e * D * DE, D, DE, DE / 64, gu, scr, r, F.lane, [](int n) { return n; }, [](int n) { return 256 * (n >> 7) + 128 + (n & 127); }); continue; } r -= I_G;
        p0_transpose_item(w_d + (size_t)e * DE * D, DE, D, D / 64, dn, scr, r, F.lane, [](int n) { return n; }, [](int n) { return n; });
    }
    LDS_WAIT();
    __syncthreads();
}

constexpr int EXP_ITEMS = NE * (2 * (D / 64) * (DE / 64) + (DE / 64) * (D / 64)) + 2 * (512 / 64) * (D / 64) + (D / 64) * (D / 64);
#ifndef MK_EXP_SPLIT_A
#define MK_EXP_SPLIT_A 3072
#define MK_EXP_SPLIT_B 6144
#define MK_EXP_SPLIT_C 9216
#define MK_EXP_SPLIT_D 12288
#endif
struct SchedP1 {
    int G, c; const char* A; const char* B;
    __device__ __forceinline__ void a_ready(const Unit&) const {}
    __device__ __forceinline__ bool next(int i, Unit& u) const { if (!tile_order(i, G, c, T / BM, NPAD / BM, u.pm, u.pn)) return false; u.aux = 0; u.A = A + (size_t)u.pm * BM * D * 2; u.B = B + (size_t)u.pn * BM * D * 2; return true; }
    __device__ __forceinline__ void lane_offs(const Unit&, int tid, unsigned (&vo)[2][2]) const {
#pragma unroll
        for (int i = 0; i < 2; ++i) { int R, C; stage_rc(tid * 16 + i * 8192, R, C); vo[0][i] = (unsigned)(R * D + C) * 2u; vo[1][i] = (unsigned)((R + HALF) * D + C) * 2u; }
    }
};
struct EpiP1 {
    static constexpr bool PERM = true;
    bf16* PA; bf16* MG; float* GM; const float* merge_b; const float* gate_b;
    __device__ __forceinline__ void operator()(const f32x4 (&acc)[2][2][4][2], const Unit& u, int wr, int wc, int fr, int fq) const {
        const int row0 = u.pm * BM + wr * 64 + fr;
        if (u.pn < 11) {
            const int col0 = u.pn * BM + wc * 32 + 8 * fq;
#pragma unroll
            for (int ai = 0; ai < 2; ++ai)
#pragma unroll
                for (int m = 0; m < 4; ++m) { bf16* rowp = PA + (size_t)(row0 + ai * HALF + m * 16) * PA_LD + col0;
#pragma unroll
                    for (int bj = 0; bj < 2; ++bj) { const f32x4 v0 = acc[ai][bj][m][0], v1 = acc[ai][bj][m][1];
                        u32x4 w; w.x = cvt_pk_bf16(v0[0], v0[1]); w.y = cvt_pk_bf16(v0[2], v0[3]); w.z = cvt_pk_bf16(v1[0], v1[1]); w.w = cvt_pk_bf16(v1[2], v1[3]);
                        *(u32x4*)(rowp + bj * HALF) = w; } }
        } else if (u.pn < 19) {
            const int col0 = (u.pn - 11) * BM + wc * 32 + 8 * fq;
            f32x4 bv[2][2];
#pragma unroll
            for (int bj = 0; bj < 2; ++bj)
#pragma unroll
                for (int n = 0; n < 2; ++n) bv[bj][n] = *(const f32x4*)(merge_b + col0 + bj * HALF + 4 * n);
#pragma unroll
            for (int ai = 0; ai < 2; ++ai)
#pragma unroll
                for (int m = 0; m < 4; ++m) { bf16* rowp = MG + (size_t)(row0 + ai * HALF + m * 16) * 2048 + col0;
#pragma unroll
                    for (int bj = 0; bj < 2; ++bj) { f32x4 v0 = acc[ai][bj][m][0] + bv[bj][0], v1 = acc[ai][bj][m][1] + bv[bj][1];
#pragma unroll
                        for (int j = 0; j < 4; ++j) { v0[j] = sigm(v0[j]); v1[j] = sigm(v1[j]); }
                        u32x4 w; w.x = cvt_pk_bf16(v0[0], v0[1]); w.y = cvt_pk_bf16(v0[2], v0[3]); w.z = cvt_pk_bf16(v1[0], v1[1]); w.w = cvt_pk_bf16(v1[2], v1[3]);
                        *(u32x4*)(rowp + bj * HALF) = w; } }
        } else {
            if (wc == 0 && fq < 2) {
                const f32x4 b0 = *(const f32x4*)(gate_b + 8 * fq), b1 = *(const f32x4*)(gate_b + 8 * fq + 4);
#pragma unroll
                for (int ai = 0; ai < 2; ++ai)
#pragma unroll
                    for (int m = 0; m < 4; ++m) { float* rowp = GM + (size_t)(row0 + ai * HALF + m * 16) * 16 + 8 * fq;
                        *(f32x4*)(rowp) = acc[ai][0][m][0] + b0; *(f32x4*)(rowp + 4) = acc[ai][0][m][1] + b1; }
            }
        }
    }
};

constexpr int AT_K_OFF = 0;
constexpr int AT_VT_OFF = 49152, AT_VT_LD = 396;
constexpr int AT_TAB_OFF = AT_VT_OFF + 64 * AT_VT_LD * 2;
constexpr int AT_TAB_LD = 328;
constexpr int AT_BKT_OFF = AT_TAB_OFF + 4 * AT_TAB_LD * 4;
constexpr int AT_LDS_END = AT_BKT_OFF + 4 * 32 * 4;
static_assert(AT_LDS_END <= RING_BYTES, "attention LDS");
constexpr float LOG2E = 1.4426950408889634f;

__device__ __forceinline__ int t5_bucket(int rel) {
    const int sign = rel > 0 ? 16 : 0; const int n = rel < 0 ? -rel : rel;
    if (n < 8) return sign + n;
    int k = 0; while (64 * (2 << k) <= n * n) ++k;
    int large = 8 + k; if (large > 15) large = 15;
    return sign + large;
}
__device__ __forceinline__ int crow(int r, int hi) { return (r & 3) + 8 * (r >> 2) + 4 * hi; }
__device__ __forceinline__ float x32_max(float v) { const auto rr = __builtin_amdgcn_permlane32_swap(__float_as_uint(v), __float_as_uint(v), false, false); return fmaxf(__uint_as_float(rr[0]), __uint_as_float(rr[1])); }
__device__ __forceinline__ float x32_sum(float v) { const auto rr = __builtin_amdgcn_permlane32_swap(__float_as_uint(v), __float_as_uint(v), false, false); return __uint_as_float(rr[0]) + __uint_as_float(rr[1]); }

__device__ __forceinline__ void conv_issue(Frame& F, const Args& a, int cu, u32x4 (&win)[12]) {
    const bf16* PA = (const bf16*)(a.ws + WS_E);
    int tz = F.tid; asm volatile("" : "+v"(tz));
    const int c8 = tz & 127, rg = tz >> 7;
    const int t0 = cu * 32 + rg * 8, s0 = t0 & (S - 1);
#pragma unroll
    for (int i = 0; i < 12; ++i) { const int sp = s0 + i - 2; const bool ok = sp >= 0 && sp < S;
        win[i] = *(const GAS u32x4*)(PA + (size_t)(ok ? t0 + i - 2 : t0) * PA_LD + PC_QM + 8 * c8); if (!ok) win[i] = (u32x4){0u, 0u, 0u, 0u}; }
}
__device__ __forceinline__ void conv_finish(Frame& F, const Args& a, int cu, const u32x4 (&win)[12]) {
    bf16* QK = (bf16*)(a.ws + WS_D);
    const float* cw = a.in[7]; const float* cb = a.in[8];
    int tz = F.tid; asm volatile("" : "+v"(tz));
    const int c8 = tz & 127, rg = tz >> 7;
    const int t0 = cu * 32 + rg * 8;
    float w[5][8], bias[8];
#pragma unroll
    for (int j = 0; j < 5; ++j) { const f32x4 x0 = *(const GAS f32x4*)(cw + j * 1024 + 8 * c8), x1 = *(const GAS f32x4*)(cw + j * 1024 + 8 * c8 + 4);
        w[j][0] = x0.x; w[j][1] = x0.y; w[j][2] = x0.z; w[j][3] = x0.w; w[j][4] = x1.x; w[j][5] = x1.y; w[j][6] = x1.z; w[j][7] = x1.w; }
    { const f32x4 x0 = *(const GAS f32x4*)(cb + 8 * c8), x1 = *(const GAS f32x4*)(cb + 8 * c8 + 4);
        bias[0] = x0.x; bias[1] = x0.y; bias[2] = x0.z; bias[3] = x0.w; bias[4] = x1.x; bias[5] = x1.y; bias[6] = x1.z; bias[7] = x1.w; }
#pragma unroll
    for (int r = 0; r < 8; ++r) {
        float acc[8];
#pragma unroll
        for (int e = 0; e < 8; ++e) acc[e] = bias[e];
#pragma unroll
        for (int j = 0; j < 5; ++j) { const u32x4 x = win[r + j];
            acc[0] += w[j][0] * bf_lo(x.x); acc[1] += w[j][1] * bf_hi(x.x); acc[2] += w[j][2] * bf_lo(x.y); acc[3] += w[j][3] * bf_hi(x.y);
            acc[4] += w[j][4] * bf_lo(x.z); acc[5] += w[j][5] * bf_hi(x.z); acc[6] += w[j][6] * bf_lo(x.w); acc[7] += w[j][7] * bf_hi(x.w); }
#pragma unroll
        for (int e = 0; e < 8; ++e) acc[e] = acc[e] * sigm(acc[e]);
        u32x4 o; o.x = cvt_pk_bf16(acc[0], acc[1]); o.y = cvt_pk_bf16(acc[2], acc[3]); o.z = cvt_pk_bf16(acc[4], acc[5]); o.w = cvt_pk_bf16(acc[6], acc[7]);
        *(GAS u32x4*)(QK + (size_t)(t0 + r) * 1024 + 8 * c8) = o;
    }
}
__device__ __forceinline__ void attn_unit(Frame& F, const Args& a, int b, int nb, int kv, int cu0, int cu1) {
    LAS unsigned char* lds = F.lds;
    const bf16* PA = (const bf16*)(a.ws + WS_E);
    bf16* YA = (bf16*)(a.ws + WS_YA);
    const float* qg = a.in[3]; const float* kg = a.in[4]; const float* sink = a.in[5]; const float* relt = a.in[6];
    int tid_ = F.tid; asm volatile("" : "+v"(tid_));
    const int tid = tid_, lane = tid & 63, wid = F.wave;
    const size_t row_band0 = (size_t)b * S + (size_t)(nb - 1) * 128;
    const int g = wid >> 1, h = kv * 4 + g, r32 = lane & 31, hi = lane >> 5;
    {
        const int c = tid & 7;
        f32x4 g0 = *(const GAS f32x4*)(kg + 8 * c), g1 = *(const GAS f32x4*)(kg + 8 * c + 4);
        u32x4 krs[6], vrs[6];
#pragma unroll
        for (int it = 0; it < 6; ++it) {
            const int kpos = (nb - 1) * 128 + (tid >> 3) + 64 * it; const bool ok = kpos >= 0 && kpos < S;
            const bf16* rp = PA + ((size_t)b * S + (size_t)(ok ? kpos : 0)) * PA_LD;
            krs[it] = *(const GAS u32x4*)(rp + PC_KA + kv * 64 + 8 * c); vrs[it] = *(const GAS u32x4*)(rp + PC_VA + kv * 64 + 8 * c);
        }
#pragma unroll
        for (int it = 0; it < 6; ++it) {
            const int key = (tid >> 3) + 64 * it;
            const int kpos = (nb - 1) * 128 + key;
            const bool ok = kpos >= 0 && kpos < S;
            u32x4 kr = krs[it], vr = vrs[it];
            if (!ok) { kr = (u32x4){0u, 0u, 0u, 0u}; vr = (u32x4){0u, 0u, 0u, 0u}; }
            float kf[8] = {bf_lo(kr.x), bf_hi(kr.x), bf_lo(kr.y), bf_hi(kr.y), bf_lo(kr.z), bf_hi(kr.z), bf_lo(kr.w), bf_hi(kr.w)};
            float ss = 0.f;
#pragma unroll
            for (int j = 0; j < 8; ++j) ss += kf[j] * kf[j];
            ss = DPP_ADD(ss, 0xB1, 0xF); ss = DPP_ADD(ss, 0x4E, 0xF); ss = DPP_ADD(ss, 0x141, 0xF);
            const float rs = rsqrtf(ss * (1.f / 64.f) + 1e-6f);
            u32x4 kn; kn.x = pk2(kf[0] * rs * g0.x, kf[1] * rs * g0.y); kn.y = pk2(kf[2] * rs * g0.z, kf[3] * rs * g0.w);
            kn.z = pk2(kf[4] * rs * g1.x, kf[5] * rs * g1.y); kn.w = pk2(kf[6] * rs * g1.z, kf[7] * rs * g1.w);
            *(LAS u32x4*)(lds + AT_K_OFF + key * 128 + ((c ^ (key & 7)) << 4)) = kn;
            LAS bf16* vt = (LAS bf16*)(lds + AT_VT_OFF) + (8 * c) * AT_VT_LD + key;
            vt[0 * AT_VT_LD] = (bf16)(vr.x & 0xffff); vt[1 * AT_VT_LD] = (bf16)(vr.x >> 16); vt[2 * AT_VT_LD] = (bf16)(vr.y & 0xffff); vt[3 * AT_VT_LD] = (bf16)(vr.y >> 16);
            vt[4 * AT_VT_LD] = (bf16)(vr.z & 0xffff); vt[5 * AT_VT_LD] = (bf16)(vr.z >> 16); vt[6 * AT_VT_LD] = (bf16)(vr.w & 0xffff); vt[7 * AT_VT_LD] = (bf16)(vr.w >> 16);
        }
        LAS float* tab = (LAS float*)(lds + AT_TAB_OFF);
        for (int i = tid; i < 4 * AT_TAB_LD; i += NWAVES * 64) { const int gg = i / AT_TAB_LD, e = i - gg * AT_TAB_LD; const int rel = e - 160;
            tab[i] = (rel >= -128 && rel <= 128) ? relt[t5_bucket(rel) * 8 + kv * 4 + gg] * LOG2E : 0.f; }
    }
    LDS_WAIT();
    __syncthreads();
    const float sink2 = sink[h] * LOG2E;
    const LAS float* tabh = (const LAS float*)(lds + AT_TAB_OFF) + g * AT_TAB_LD;
    u32x4 cwin[12];
    if (cu0 >= 0) conv_issue(F, a, cu0, cwin);
    for (int grp = 0; grp < 2; ++grp) {
        const int qoff = 64 * (wid & 1) + 32 * grp + r32;
        const size_t qrow = (size_t)b * S + (size_t)nb * 128 + qoff;
        bf16x8 qf[4];
        {
            u32x4 raw[4]; float ss = 0.f;
#pragma unroll
            for (int s = 0; s < 4; ++s) { raw[s] = *(const GAS u32x4*)(PA + qrow * PA_LD + PC_QA + h * 64 + 16 * s + 8 * hi);
                const unsigned w[4] = {raw[s].x, raw[s].y, raw[s].z, raw[s].w};
#pragma unroll
                for (int j = 0; j < 4; ++j) { const float lo = bf_lo(w[j]), hh = bf_hi(w[j]); ss += lo * lo + hh * hh; } }
            ss = x32_sum(ss);
            const float rs = rsqrtf(ss * (1.f / 64.f) + 1e-6f) * (0.125f * LOG2E);
#pragma unroll
            for (int s = 0; s < 4; ++s) { const f32x4 g0 = *(const GAS f32x4*)(qg + 16 * s + 8 * hi), g1 = *(const GAS f32x4*)(qg + 16 * s + 8 * hi + 4);
                u32x4 o; o.x = pk2(bf_lo(raw[s].x) * rs * g0.x, bf_hi(raw[s].x) * rs * g0.y); o.y = pk2(bf_lo(raw[s].y) * rs * g0.z, bf_hi(raw[s].y) * rs * g0.w);
                o.z = pk2(bf_lo(raw[s].z) * rs * g1.x, bf_hi(raw[s].z) * rs * g1.y); o.w = pk2(bf_lo(raw[s].w) * rs * g1.z, bf_hi(raw[s].w) * rs * g1.w);
                qf[s] = __builtin_bit_cast(bf16x8, o); }
        }
        float m = sink2, l = (hi == 0) ? 1.f : 0.f;
        f32x16 o0 = {}, o1 = {};
        const int qoff_g = 64 * (wid & 1) + 32 * grp;
        const int kt0 = qoff_g / 32, klo = (nb == 0 && kt0 < 4) ? 4 : kt0, khi = (nb == 15 && kt0 + 8 > 7) ? 7 : kt0 + 8;
#define AT_QK(dst, ktile) do { dst = (f32x16){}; _Pragma("unroll") for (int s = 0; s < 4; ++s) { const int key = 32 * (ktile) + r32; const int ch = 2 * s + hi; \
            const bf16x8 kfr = *(const LAS bf16x8*)(lds + AT_K_OFF + key * 128 + ((ch ^ (key & 7)) << 4)); dst = __builtin_amdgcn_mfma_f32_32x32x16_bf16(kfr, qf[s], dst, 0, 0, 0); } } while (0)
        for (int kt = klo; kt <= khi; ++kt) {
            const int key0 = 32 * kt;
            f32x16 p; AT_QK(p, kt);
            const int tb = key0 + 4 * hi - qoff + 32;
            float tmax = -3.0e38f;
            if (kt == kt0 || kt == kt0 + 8) {
#pragma unroll
                for (int r = 0; r < 16; ++r) { const int rel = key0 + crow(r, hi) - 128 - qoff;
                    const float sv = (rel >= -128 && rel <= 128) ? p[r] + tabh[tb + (r & 3) + 8 * (r >> 2)] : -1.0e30f;
                    p[r] = sv; tmax = fmaxf(tmax, sv); }
            } else {
#pragma unroll
                for (int r = 0; r < 16; ++r) { const float sv = p[r] + tabh[tb + (r & 3) + 8 * (r >> 2)]; p[r] = sv; tmax = fmaxf(tmax, sv); }
            }
            tmax = x32_max(tmax);
            const float mn = fmaxf(m, tmax);
            if (__any(mn > m)) { const float al = __builtin_amdgcn_exp2f(m - mn); l *= al;
#pragma unroll
                for (int r = 0; r < 16; ++r) { o0[r] *= al; o1[r] *= al; } }
            m = mn;
            float ps = 0.f;
#pragma unroll
            for (int r = 0; r < 16; ++r) { p[r] = __builtin_amdgcn_exp2f(p[r] - m); ps += p[r]; }
            l += ps;
#pragma unroll
            for (int s = 0; s < 2; ++s) {
                u32x4 pw; pw.x = cvt_pk_bf16(p[8 * s + 0], p[8 * s + 1]); pw.y = cvt_pk_bf16(p[8 * s + 2], p[8 * s + 3]); pw.z = cvt_pk_bf16(p[8 * s + 4], p[8 * s + 5]); pw.w = cvt_pk_bf16(p[8 * s + 6], p[8 * s + 7]);
                const bf16x8 pf = __builtin_bit_cast(bf16x8, pw);
#pragma unroll
                for (int dt = 0; dt < 2; ++dt) {
                    const LAS unsigned char* vp = lds + AT_VT_OFF + (32 * dt + r32) * (AT_VT_LD * 2) + (key0 + 16 * s + 4 * hi) * 2;
                    const u32x2 lo = *(const LAS u32x2*)(vp), hh = *(const LAS u32x2*)(vp + 16);
                    const bf16x8 vf = __builtin_bit_cast(bf16x8, (u32x4){lo.x, lo.y, hh.x, hh.y});
                    if (dt == 0) o0 = __builtin_amdgcn_mfma_f32_32x32x16_bf16(vf, pf, o0, 0, 0, 0); else o1 = __builtin_amdgcn_mfma_f32_32x32x16_bf16(vf, pf, o1, 0, 0, 0);
                }
            }
        }
#undef AT_QK
        l = x32_sum(l);
        const float inv = __builtin_amdgcn_rcpf(l);
        bf16* orow = YA + qrow * 512 + h * 64;
#pragma unroll
        for (int k = 0; k < 4; ++k) {
            u32x2 w0, w1; w0.x = cvt_pk_bf16(o0[4 * k] * inv, o0[4 * k + 1] * inv); w0.y = cvt_pk_bf16(o0[4 * k + 2] * inv, o0[4 * k + 3] * inv);
            w1.x = cvt_pk_bf16(o1[4 * k] * inv, o1[4 * k + 1] * inv); w1.y = cvt_pk_bf16(o1[4 * k + 2] * inv, o1[4 * k + 3] * inv);
            *(GAS u32x2*)(orow + 8 * k + 4 * hi) = w0; *(GAS u32x2*)(orow + 32 + 8 * k + 4 * hi) = w1;
        }
        if (grp == 0) { if (cu0 >= 0) conv_finish(F, a, cu0, cwin); if (cu1 >= 0) conv_issue(F, a, cu1, cwin); }
        else if (cu1 >= 0) conv_finish(F, a, cu1, cwin);
    }
    __syncthreads();
}

__device__ __forceinline__ void p2a_phase(Frame& F, const Args& a) {
    for (int u = F.vcu; u < Bz * 16 * 2; u += F.G) { const int kv = u & 1, nb = (u >> 1) & 15, b = u >> 5; attn_unit(F, a, b, nb, kv, 2 * u, 2 * u + 1); }
}

constexpr int ML_WL = 13824;
constexpr int ML_QQ = 0, ML_KQ = 4096, ML_VV = 8192, ML_SC = 12288;
constexpr int SC_WS = 0, SC_G = 256, SC_INTER = 512, SC_FLOOR = 768, SC_N = 1024;
constexpr int ML_BATON = 8 * ML_WL;
constexpr int ML_BN = ML_BATON + 16384, ML_BM = ML_BN + 512, ML_BFLAG = ML_BM + 16;
static_assert(ML_BFLAG + 16 <= RING_BYTES, "mLSTM LDS");
constexpr float LN_KS = -2.4260151319598084f;
constexpr float KS = 0.08838834764831845f;

__device__ __forceinline__ int ml_off(int row, int ch) { return row * 64 + ((ch ^ ((row >> 2) & 3)) << 4); }
__device__ __forceinline__ s16x4 tr_read(const LAS unsigned char* p) {
    typedef short v4i16_t __attribute__((ext_vector_type(4)));
    return __builtin_bit_cast(s16x4, __builtin_amdgcn_ds_read_tr16_b64_v4i16((LAS v4i16_t*)p));
}
__device__ __forceinline__ bf16x8 cat4(s16x4 a, s16x4 b) { return (bf16x8){a[0], a[1], a[2], a[3], b[0], b[1], b[2], b[3]}; }
__device__ __forceinline__ bf16x8 pack8(float a0, float a1, float a2, float a3, float a4, float a5, float a6, float a7) {
    u32x4 w; w.x = cvt_pk_bf16(a0, a1); w.y = cvt_pk_bf16(a2, a3); w.z = cvt_pk_bf16(a4, a5); w.w = cvt_pk_bf16(a6, a7); return __builtin_bit_cast(bf16x8, w);
}
__device__ __forceinline__ float bfs(short v) { return __builtin_bit_cast(float, ((unsigned)(unsigned short)v) << 16); }

__device__ __forceinline__ void mlstm_chunk(Frame& F, const Args& a, int b, int h, int dir, int es, int j) {
    int lane_ = F.lane; asm volatile("" : "+v"(lane_));
    const int lane = lane_, r32 = lane & 31, hi = lane >> 5, blk = (lane >> 4) & 1, q4 = (lane & 15) >> 2, p = lane & 3;
    LAS unsigned char* wl = F.lds + F.wave * ML_WL;
    LAS float* SCf = (LAS float*)(wl + ML_SC);
    const bf16* PA = (const bf16*)(a.ws + WS_E); const bf16* QC = (const bf16*)(a.ws + WS_D); const float* GM = (const float*)(a.ws + WS_GM);
    const int swzA = (r32 >> 2) & 3;
    const int rd0o = r32 * 64 + ((hi ^ swzA) << 4);
    const int ch = 2 * blk + (p >> 1), bo = 8 * (p & 1);
    LAS unsigned char* trA0 = wl + 512 * hi + 64 * q4 + ((ch ^ (2 * hi)) << 4) + bo;
    LAS unsigned char* trA1 = wl + 512 * hi + 64 * q4 + 256 + ((ch ^ (2 * hi + 1)) << 4) + bo;
    LAS unsigned char* trB0 = wl + 256 * hi + 64 * q4 + ((ch ^ hi) << 4) + bo;
    LAS unsigned char* trB1 = wl + 256 * hi + 64 * q4 + 512 + ((ch ^ (hi + 2)) << 4) + bo;
    LAS unsigned char* stg = wl + (lane >> 2) * 64 + (((lane & 3) ^ ((lane >> 4) & 3)) << 4);
    const int rdq = r32 * 64 + (swzA << 4) + 8 * hi;
    const int lowtok = b * S + (dir ? (S - 64 - 64 * j) : 64 * j);
    const int L0 = dir ? 15 - (lane >> 2) : (lane >> 2);
    const unsigned voQ = (unsigned)(L0 * 2048 + 16 * (lane & 3)), voP = (unsigned)(L0 * (PA_LD * 2) + 16 * (lane & 3));
#define ML_UG(it) (16 * (dir ? 3 - (it) : (it)))
#define ML_QPTR(it, col) ((const char*)QC + ((size_t)(lowtok + ML_UG(it)) * 1024 + (size_t)(col)) * 2 + voQ)
    float bcum, gval, Gmax, b_last, G63;
    {
        const float* gp = (const float*)((const char*)GM + ((size_t)lowtok * 16 + dir * 8 + h) * 4 + (unsigned)((dir ? 63 - lane : lane) * 64));
        const float ig = gp[0], fg = gp[4];
        const float lf = fminf(fg, 0.f) - 0.6931471805599453f * __builtin_amdgcn_logf(1.f + __builtin_amdgcn_exp2f(-1.4426950408889634f * fabsf(fg)));
#define ML_DPP(v, idn, ctrl, rm) __builtin_bit_cast(float, __builtin_amdgcn_update_dpp(__builtin_bit_cast(int, (float)(idn)), __builtin_bit_cast(int, (v)), (ctrl), (rm), 0xF, false))
        bcum = lf;
        bcum += ML_DPP(bcum, 0.f, 0x111, 0xF); bcum += ML_DPP(bcum, 0.f, 0x112, 0xF); bcum += ML_DPP(bcum, 0.f, 0x114, 0xF); bcum += ML_DPP(bcum, 0.f, 0x118, 0xF);
        bcum += ML_DPP(bcum, 0.f, 0x142, 0xA); bcum += ML_DPP(bcum, 0.f, 0x143, 0xC);
        gval = ig - bcum; Gmax = gval;
        Gmax = fmaxf(Gmax, ML_DPP(Gmax, -3.0e38f, 0x111, 0xF)); Gmax = fmaxf(Gmax, ML_DPP(Gmax, -3.0e38f, 0x112, 0xF)); Gmax = fmaxf(Gmax, ML_DPP(Gmax, -3.0e38f, 0x114, 0xF)); Gmax = fmaxf(Gmax, ML_DPP(Gmax, -3.0e38f, 0x118, 0xF));
        Gmax = fmaxf(Gmax, ML_DPP(Gmax, -3.0e38f, 0x142, 0xA)); Gmax = fmaxf(Gmax, ML_DPP(Gmax, -3.0e38f, 0x143, 0xC));
#undef ML_DPP
        b_last = __builtin_bit_cast(float, __builtin_amdgcn_readlane(__builtin_bit_cast(int, bcum), 63)); G63 = __builtin_bit_cast(float, __builtin_amdgcn_readlane(__builtin_bit_cast(int, Gmax), 63));
        SCf[SC_WS / 4 + lane] = __expf(gval - G63); SCf[SC_G / 4 + lane] = gval;
    }
    asm volatile("" ::: "memory"); __builtin_amdgcn_sched_barrier(0);
#pragma unroll
    for (int it = 0; it < 4; ++it) { const u32x4 v = *(const GAS u32x4*)((const char*)PA + ((size_t)(lowtok + ML_UG(it)) * PA_LD + PC_VM + h * 128 + es * 32) * 2 + voP);
        *(LAS u32x4*)(stg + ML_VV + 1024 * it) = v; }
    asm volatile("" ::: "memory"); __builtin_amdgcn_sched_barrier(0);
    f32x16 ST[2][2]; f32x16 dC[4]; f32x16 dn = {};
#pragma unroll
    for (int x = 0; x < 2; ++x)
#pragma unroll
        for (int y = 0; y < 2; ++y) ST[x][y] = (f32x16){};
#pragma unroll
    for (int x = 0; x < 4; ++x) dC[x] = (f32x16){};
    bf16x8 wvf[4]; u32x4 wsp[4];
#pragma unroll
    for (int ks = 0; ks < 4; ++ks) {
        const s16x4 v0 = tr_read(trA0 + ML_VV + 1024 * ks), v1 = tr_read(trA1 + ML_VV + 1024 * ks);
        const f32x4 w0 = *(const LAS f32x4*)(SCf + SC_WS / 4 + 16 * ks + 8 * hi), w1 = *(const LAS f32x4*)(SCf + SC_WS / 4 + 16 * ks + 8 * hi + 4);
        wvf[ks] = pack8(bfs(v0[0]) * w0.x, bfs(v0[1]) * w0.y, bfs(v0[2]) * w0.z, bfs(v0[3]) * w0.w, bfs(v1[0]) * w1.x, bfs(v1[1]) * w1.y, bfs(v1[2]) * w1.z, bfs(v1[3]) * w1.w);
        wsp[ks] = (u32x4){cvt_pk_bf16(w0.x, w0.y), cvt_pk_bf16(w0.z, w0.w), cvt_pk_bf16(w1.x, w1.y), cvt_pk_bf16(w1.z, w1.w)};
    }
    u32x4 pq[4], pk[4];
#pragma unroll
    for (int it = 0; it < 4; ++it) { pq[it] = *(const GAS u32x4*)ML_QPTR(it, h * 128); pk[it] = *(const GAS u32x4*)ML_QPTR(it, 512 + h * 128); }
#pragma unroll
    for (int q = 0; q < 4; ++q) {
        asm volatile("" ::: "memory"); __builtin_amdgcn_sched_barrier(0);
#pragma unroll
        for (int it = 0; it < 4; ++it) { *(LAS u32x4*)(stg + ML_QQ + 1024 * it) = pq[it]; *(LAS u32x4*)(stg + ML_KQ + 1024 * it) = pk[it]; }
        if (q < 3) {
#pragma unroll
            for (int it = 0; it < 4; ++it) { pq[it] = *(const GAS u32x4*)ML_QPTR(it, h * 128 + 32 * (q + 1)); pk[it] = *(const GAS u32x4*)ML_QPTR(it, 512 + h * 128 + 32 * (q + 1)); }
        } else {
#pragma unroll
            for (int it = 0; it < 4; ++it) pq[it] = *(const GAS u32x4*)ML_QPTR(it, h * 128);
        }
        asm volatile("" ::: "memory"); __builtin_amdgcn_sched_barrier(0);
#pragma unroll
        for (int ks = 0; ks < 2; ++ks) {
            bf16x8 kf[2], qf[2];
            LAS unsigned char* rr = wl + (ks ? (rd0o ^ 32) : rd0o);
#pragma unroll
            for (int x = 0; x < 2; ++x) { kf[x] = *(const LAS bf16x8*)(rr + ML_KQ + 2048 * x); qf[x] = *(const LAS bf16x8*)(rr + ML_QQ + 2048 * x); }
#pragma unroll
            for (int st = 0; st < 2; ++st)
#pragma unroll
                for (int tt = 0; tt < 2; ++tt) ST[st][tt] = __builtin_amdgcn_mfma_f32_32x32x16_bf16(kf[st], qf[tt], ST[st][tt], 0, 0, 0);
        }
#pragma unroll
        for (int ks = 0; ks < 4; ++ks) {
            const bf16x8 ka = cat4(tr_read(trA0 + ML_KQ + 1024 * ks), tr_read(trA1 + ML_KQ + 1024 * ks));
            const bf16x8 wv = wvf[ks];
            const bool selq = (r32 == q);
            const bf16x8 wn = __builtin_bit_cast(bf16x8, (u32x4){selq ? wsp[ks].x : 0u, selq ? wsp[ks].y : 0u, selq ? wsp[ks].z : 0u, selq ? wsp[ks].w : 0u});
            dC[q] = __builtin_amdgcn_mfma_f32_32x32x16_bf16(ka, wv, dC[q], 0, 0, 0);
            dn = __builtin_amdgcn_mfma_f32_32x32x16_bf16(ka, wn, dn, 0, 0, 0);
        }
    }
    u32x4 STp[2][2][2];
#pragma unroll
    for (int st = 0; st < 2; ++st)
#pragma unroll
        for (int tt = 0; tt < 2; ++tt)
#pragma unroll
            for (int ks = 0; ks < 2; ++ks) STp[st][tt][ks] = (u32x4){cvt_pk_bf16(ST[st][tt][8 * ks], ST[st][tt][8 * ks + 1]), cvt_pk_bf16(ST[st][tt][8 * ks + 2], ST[st][tt][8 * ks + 3]), cvt_pk_bf16(ST[st][tt][8 * ks + 4], ST[st][tt][8 * ks + 5]), cvt_pk_bf16(ST[st][tt][8 * ks + 6], ST[st][tt][8 * ks + 7])};
    asm volatile("" ::: "memory"); __builtin_amdgcn_sched_barrier(0);
    volatile LAS unsigned* flag = (volatile LAS unsigned*)(F.lds + ML_BFLAG);
    while (*flag != (unsigned)j) __builtin_amdgcn_s_sleep(1);
    asm volatile("" ::: "memory");
    LAS float* BC = (LAS float*)(F.lds + ML_BATON) + lane * 4; LAS float* BN = (LAS float*)(F.lds + ML_BN); LAS float* BMp = (LAS float*)(F.lds + ML_BM);
    const float m_prev = BMp[0];
    const float M63 = fmaxf(m_prev, G63);
    const float decay = __expf(m_prev - M63), fsc = __expf(G63 - M63) * KS;
    u32x4 Cb[4][2];
#pragma unroll
    for (int dt = 0; dt < 4; ++dt) {
        f32x4 c[4];
#pragma unroll
        for (int k = 0; k < 4; ++k) c[k] = *(const LAS f32x4*)(BC + (dt * 4 + k) * 256);
        Cb[dt][0] = (u32x4){cvt_pk_bf16(c[0].x, c[0].y), cvt_pk_bf16(c[0].z, c[0].w), cvt_pk_bf16(c[1].x, c[1].y), cvt_pk_bf16(c[1].z, c[1].w)};
        Cb[dt][1] = (u32x4){cvt_pk_bf16(c[2].x, c[2].y), cvt_pk_bf16(c[2].z, c[2].w), cvt_pk_bf16(c[3].x, c[3].y), cvt_pk_bf16(c[3].z, c[3].w)};
#pragma unroll
        for (int k = 0; k < 4; ++k) { f32x4 nw; nw.x = decay * c[k].x + fsc * dC[dt][4 * k]; nw.y = decay * c[k].y + fsc * dC[dt][4 * k + 1]; nw.z = decay * c[k].z + fsc * dC[dt][4 * k + 2]; nw.w = decay * c[k].w + fsc * dC[dt][4 * k + 3];
            *(LAS f32x4*)(BC + (dt * 4 + k) * 256) = nw; }
    }
    {
        const float n0 = BN[lane], n1 = BN[lane + 64];
        SCf[SC_N / 4 + lane] = n0; SCf[SC_N / 4 + lane + 64] = n1;
        LDS_WAIT();
        if (r32 < 4) {
#pragma unroll
            for (int k = 0; k < 4; ++k) { const int d0 = 32 * r32 + 8 * k + 4 * hi; const f32x4 np = *(const LAS f32x4*)(SCf + SC_N / 4 + d0);
                f32x4 nw; nw.x = decay * np.x + fsc * dn[4 * k]; nw.y = decay * np.y + fsc * dn[4 * k + 1]; nw.z = decay * np.z + fsc * dn[4 * k + 2]; nw.w = decay * np.w + fsc * dn[4 * k + 3];
                *(LAS f32x4*)(BN + d0) = nw; }
        }
        if (lane == 0) BMp[0] = b_last + M63;
    }
    LDS_WAIT();
    asm volatile("" ::: "memory");
    if (lane == 0) *flag = (unsigned)(j + 1);
    asm volatile("" ::: "memory");
    asm volatile("" ::: "memory"); __builtin_amdgcn_sched_barrier(0);
    const float Mrow = fmaxf(m_prev, Gmax);
    SCf[SC_INTER / 4 + lane] = __expf(m_prev - Mrow); SCf[SC_FLOOR / 4 + lane] = __expf(-bcum - Mrow);
    asm volatile("" ::: "memory"); __builtin_amdgcn_sched_barrier(0);
    f32x16 Z[2], dI[2];
    Z[0] = (f32x16){}; Z[1] = (f32x16){}; dI[0] = (f32x16){}; dI[1] = (f32x16){};
    const bf16x8 ones = (bf16x8){0x3F80, 0x3F80, 0x3F80, 0x3F80, 0x3F80, 0x3F80, 0x3F80, 0x3F80};
    float ex2[2]; ex2[0] = __expf(G63 - __shfl(Mrow, r32) + LN_KS); ex2[1] = __expf(G63 - __shfl(Mrow, r32 + 32) + LN_KS);
#pragma unroll
    for (int st = 0; st < 2; ++st)
#pragma unroll
        for (int ks = 0; ks < 2; ++ks) {
            const bf16x8 vb = cat4(tr_read(trB0 + ML_VV + 2048 * st + 1024 * ks), tr_read(trB1 + ML_VV + 2048 * st + 1024 * ks));
            const int s0 = 32 * st + 16 * ks + 4 * hi;
            const f32x4 ga = *(const LAS f32x4*)(SCf + SC_WS / 4 + s0), gb = *(const LAS f32x4*)(SCf + SC_WS / 4 + s0 + 8);
            const float gg[8] = {ga.x, ga.y, ga.z, ga.w, gb.x, gb.y, gb.z, gb.w};
#pragma unroll
            for (int tt = 0; tt < 2; ++tt) {
                const int t = 32 * tt + r32; const u32x4 sp = STp[st][tt][ks];
                const float sv[8] = {bf_lo(sp.x), bf_hi(sp.x), bf_lo(sp.y), bf_hi(sp.y), bf_lo(sp.z), bf_hi(sp.z), bf_lo(sp.w), bf_hi(sp.w)};
                float pw[8];
#pragma unroll
                for (int jj = 0; jj < 8; ++jj) { const int s = s0 + (jj & 3) + 8 * (jj >> 2); pw[jj] = (s <= t) ? sv[jj] * (gg[jj] * ex2[tt]) : 0.f; }
                const bf16x8 pa = pack8(pw[0], pw[1], pw[2], pw[3], pw[4], pw[5], pw[6], pw[7]);
                Z[tt] = __builtin_amdgcn_mfma_f32_32x32x16_bf16(pa, vb, Z[tt], 0, 0, 0);
                dI[tt] = __builtin_amdgcn_mfma_f32_32x32x16_bf16(pa, ones, dI[tt], 0, 0, 0);
            }
        }
    asm volatile("" ::: "memory"); __builtin_amdgcn_sched_barrier(0);
    f32x16 QCa[2], dN[2];
    QCa[0] = (f32x16){}; QCa[1] = (f32x16){}; dN[0] = (f32x16){}; dN[1] = (f32x16){};
#pragma unroll
    for (int q = 0; q < 4; ++q) {
        asm volatile("" ::: "memory"); __builtin_amdgcn_sched_barrier(0);
#pragma unroll
        for (int it = 0; it < 4; ++it) *(LAS u32x4*)(stg + ML_QQ + 1024 * it) = pq[it];
        if (q < 3) {
#pragma unroll
            for (int it = 0; it < 4; ++it) pq[it] = *(const GAS u32x4*)ML_QPTR(it, h * 128 + 32 * (q + 1));
        }
        asm volatile("" ::: "memory"); __builtin_amdgcn_sched_barrier(0);
#pragma unroll
        for (int ks = 0; ks < 2; ++ks) {
            const int d0 = 32 * q + 16 * ks + 4 * hi;
            const f32x4 na = *(const LAS f32x4*)(SCf + SC_N / 4 + d0), nb2 = *(const LAS f32x4*)(SCf + SC_N / 4 + d0 + 8);
            const bf16x8 nf = pack8(na.x, na.y, na.z, na.w, nb2.x, nb2.y, nb2.z, nb2.w);
            const bf16x8 cf = __builtin_bit_cast(bf16x8, Cb[q][ks]);
#pragma unroll
            for (int tt = 0; tt < 2; ++tt) {
                const u32x2 lo = *(const LAS u32x2*)(wl + ML_QQ + 2048 * tt + (rdq ^ (32 * ks))), hh = *(const LAS u32x2*)(wl + ML_QQ + 2048 * tt + (rdq ^ (32 * ks + 16)));
                const bf16x8 qa = __builtin_bit_cast(bf16x8, (u32x4){lo.x, lo.y, hh.x, hh.y});
                QCa[tt] = __builtin_amdgcn_mfma_f32_32x32x16_bf16(qa, cf, QCa[tt], 0, 0, 0);
                dN[tt] = __builtin_amdgcn_mfma_f32_32x32x16_bf16(qa, nf, dN[tt], 0, 0, 0);
            }
        }
    }
    LDS_WAIT();
    asm volatile("" ::: "memory"); __builtin_amdgcn_sched_barrier(0);
    {
        const int wbo = 256 * hi + (((r32 >> 3) ^ hi) << 4) + 2 * (r32 & 7);
#pragma unroll
        for (int tt = 0; tt < 2; ++tt)
#pragma unroll
            for (int k = 0; k < 4; ++k) { const int t0 = 32 * tt + 8 * k + 4 * hi;
                const f32x4 iv = *(const LAS f32x4*)(SCf + SC_INTER / 4 + t0), fv = *(const LAS f32x4*)(SCf + SC_FLOOR / 4 + t0);
                const float ii[4] = {iv.x, iv.y, iv.z, iv.w}, ff[4] = {fv.x, fv.y, fv.z, fv.w};
#pragma unroll
                for (int e = 0; e < 4; ++e) { const int r = 4 * k + e; const float num = Z[tt][r] + ii[e] * QCa[tt][r], den = dI[tt][r] + ii[e] * dN[tt][r];
                    const float hv = num * __builtin_amdgcn_rcpf(fmaxf(fabsf(den), ff[e]));
                    *(LAS bf16*)(wl + ML_QQ + ((k & 1) ? (wbo ^ 32) : wbo) + 64 * (32 * tt + 8 * k + e)) = (bf16)(cvt_pk_bf16(hv, 0.f) & 0xffffu); } }
    }
    LDS_WAIT();
    asm volatile("" ::: "memory");
    bf16* HO = (bf16*)(a.ws + WS_E);
    const int ocol = (dir ? PC_KM : PC_QM) + h * 128 + es * 32;
#pragma unroll
    for (int it = 0; it < 4; ++it) {
        const u32x4 v = *(const LAS u32x4*)(stg + ML_QQ + 1024 * it);
        *(GAS u32x4*)((char*)HO + ((size_t)(lowtok + ML_UG(it)) * PA_LD + ocol) * 2 + voP) = v; }
    LDS_WAIT();
    asm volatile("" ::: "memory");
}

#undef ML_UG
#undef ML_QPTR
__device__ __forceinline__ void p2m_phase(Frame& F, const Args& a) {
    for (int u = F.vcu; u < Bz * 4 * 2 * 4; u += F.G) {
        const int es = u & 3, dir = (u >> 2) & 1, h = (u >> 3) & 3, b = u >> 5;
        for (int i = F.tid; i < (16384 + 512 + 32) / 4; i += NWAVES * 64) ((LAS unsigned*)(F.lds + ML_BATON))[i] = 0u;
        LDS_WAIT();
        __syncthreads();
        for (int i = 0; i < 4; ++i) mlstm_chunk(F, a, b, h, dir, es, 8 * i + F.wave);
        __syncthreads();
    }
}

__device__ __forceinline__ void p2b_phase(Frame& F, const Args& a) {
    bf16* PA = (bf16*)(a.ws + WS_E); const float* og = a.in[10];
    const int gw = F.vcu * NWAVES + F.wave, NGW = F.G * NWAVES, lane = F.lane;
    const f32x4 g0 = *(const GAS f32x4*)(og + 8 * lane), g1 = *(const GAS f32x4*)(og + 8 * lane + 4);
    for (int t = gw; t < T; t += NGW) {
        bf16* row = PA + (size_t)t * PA_LD;
        const u32x4 hf = *(const GAS u32x4*)(row + PC_QM + 8 * lane), hb = *(const GAS u32x4*)(row + PC_KM + 8 * lane), om = *(const GAS u32x4*)(row + PC_OM + 8 * lane);
        float v[8] = {bf_lo(hf.x) + bf_lo(hb.x), bf_hi(hf.x) + bf_hi(hb.x), bf_lo(hf.y) + bf_lo(hb.y), bf_hi(hf.y) + bf_hi(hb.y), bf_lo(hf.z) + bf_lo(hb.z), bf_hi(hf.z) + bf_hi(hb.z), bf_lo(hf.w) + bf_lo(hb.w), bf_hi(hf.w) + bf_hi(hb.w)};
        float ss = 0.f;
#pragma unroll
        for (int e = 0; e < 8; ++e) ss += v[e] * v[e];
        ss += __shfl_xor(ss, 1); ss += __shfl_xor(ss, 2); ss += __shfl_xor(ss, 4); ss += __shfl_xor(ss, 8);
        const float rs = rsqrtf(ss * (1.f / 128.f) + 1e-6f);
        const float o[8] = {bf_lo(om.x), bf_hi(om.x), bf_lo(om.y), bf_hi(om.y), bf_lo(om.z), bf_hi(om.z), bf_lo(om.w), bf_hi(om.w)};
        const float gg[8] = {g0.x, g0.y, g0.z, g0.w, g1.x, g1.y, g1.z, g1.w};
#pragma unroll
        for (int e = 0; e < 8; ++e) v[e] = v[e] * rs * gg[e] * sigm(o[e]);
        u32x4 w; w.x = cvt_pk_bf16(v[0], v[1]); w.y = cvt_pk_bf16(v[2], v[3]); w.z = cvt_pk_bf16(v[4], v[5]); w.w = cvt_pk_bf16(v[6], v[7]);
        if (!a.dry) *(GAS u32x4*)(row + PC_OM + 8 * lane) = w; else asm volatile("" :: "v"(w));
    }
}

__device__ __forceinline__ void p2b_rows(Frame& F, const Args& a, int row0, unsigned* pcnt) {
    bf16* PA = (bf16*)(a.ws + WS_E); const float* og = a.in[10];
    const int lane = F.lane;
    const f32x4 g0 = *(const GAS f32x4*)(og + 8 * lane), g1 = *(const GAS f32x4*)(og + 8 * lane + 4);
    const float gg[8] = {g0.x, g0.y, g0.z, g0.w, g1.x, g1.y, g1.z, g1.w};
    const __amdgpu_buffer_rsrc_t rsrc = __builtin_amdgcn_make_buffer_rsrc((void*)PA, 0, (int)((size_t)T * PA_LD * 2), 0x00020000);
    u32x4 hf[8], hb[8], om[8];
#pragma unroll
    for (int i = 0; i < 8; ++i) { const bf16* row = PA + (size_t)(row0 + F.wave * 8 + i) * PA_LD;
        hf[i] = *(const GAS u32x4*)(row + PC_QM + 8 * lane); hb[i] = *(const GAS u32x4*)(row + PC_KM + 8 * lane); om[i] = *(const GAS u32x4*)(row + PC_OM + 8 * lane); }
#pragma unroll
    for (int i = 0; i < 8; ++i) {
        float v[8] = {bf_lo(hf[i].x) + bf_lo(hb[i].x), bf_hi(hf[i].x) + bf_hi(hb[i].x), bf_lo(hf[i].y) + bf_lo(hb[i].y), bf_hi(hf[i].y) + bf_hi(hb[i].y), bf_lo(hf[i].z) + bf_lo(hb[i].z), bf_hi(hf[i].z) + bf_hi(hb[i].z), bf_lo(hf[i].w) + bf_lo(hb[i].w), bf_hi(hf[i].w) + bf_hi(hb[i].w)};
        float ss = 0.f;
#pragma unroll
        for (int e = 0; e < 8; ++e) ss += v[e] * v[e];
        ss = DPP_ADD(ss, 0xB1, 0xF); ss = DPP_ADD(ss, 0x4E, 0xF); ss = DPP_ADD(ss, 0x141, 0xF); ss = DPP_ADD(ss, 0x140, 0xF);
        const float rs = rsqrtf(ss * (1.f / 128.f) + 1e-6f);
        const float o[8] = {bf_lo(om[i].x), bf_hi(om[i].x), bf_lo(om[i].y), bf_hi(om[i].y), bf_lo(om[i].z), bf_hi(om[i].z), bf_lo(om[i].w), bf_hi(om[i].w)};
#pragma unroll
        for (int e = 0; e < 8; ++e) v[e] = v[e] * rs * gg[e] * sigm(o[e]);
        u32x4 w; w.x = cvt_pk_bf16(v[0], v[1]); w.y = cvt_pk_bf16(v[2], v[3]); w.z = cvt_pk_bf16(v[4], v[5]); w.w = cvt_pk_bf16(v[6], v[7]);
        __builtin_amdgcn_raw_buffer_store_b128(w, rsrc, (int)(((size_t)(row0 + F.wave * 8 + i) * PA_LD + PC_OM + 8 * lane) * 2), 0, 16);
    }
    asm volatile("s_waitcnt vmcnt(0)" ::: "memory");
    if (lane == 0) __hip_atomic_fetch_add(pcnt, 1u, __ATOMIC_RELAXED, __HIP_MEMORY_SCOPE_AGENT);
}


struct SchedP3a {
    int G, c; const char* PAb; const char* WaT; const char* WmT; const char* YAb; unsigned* pcnt; unsigned* tmo;
    __device__ __forceinline__ void a_ready(const Unit& u) const {
        if (!u.aux) return;
        if (threadIdx.x < 64) {
            unsigned polls = 0;
            while ((unsigned)__builtin_amdgcn_readfirstlane(__hip_atomic_load(pcnt + 64 * u.pm, __ATOMIC_RELAXED, __HIP_MEMORY_SCOPE_AGENT)) < 32u) {
                __builtin_amdgcn_s_sleep(2);
                if ((++polls & 1023u) == 0u) { if (__builtin_amdgcn_readfirstlane(__hip_atomic_load(tmo, __ATOMIC_RELAXED, __HIP_MEMORY_SCOPE_AGENT)) != 0u) break;
                    if (polls > (1u << 22)) { if (threadIdx.x == 0) __hip_atomic_store(tmo, 1u, __ATOMIC_RELAXED, __HIP_MEMORY_SCOPE_AGENT); break; } }
            }
            __builtin_amdgcn_fence(__ATOMIC_ACQUIRE, "agent");
            asm volatile("s_waitcnt vmcnt(0)" ::: "memory");
        }
        asm volatile("" ::: "memory"); __builtin_amdgcn_s_barrier(); asm volatile("" ::: "memory");
    }
    __device__ __forceinline__ bool next(int i, Unit& u) const {
        if (!tile_order(i >> 1, G, c, T / BM, D / BM, u.pm, u.pn)) return false;
        u.aux = i & 1;
        u.A = u.aux ? PAb + (size_t)u.pm * BM * PA_LD * 2 + PC_OM * 2 : YAb + (size_t)u.pm * BM * 512 * 2;
        u.B = (u.aux ? WmT : WaT) + (size_t)u.pn * BM * 512 * 2; return true;
    }
    __device__ __forceinline__ void lane_offs(const Unit& u, int tid, unsigned (&vo)[2][2]) const {
        const int ld = u.aux ? PA_LD : 512;
#pragma unroll
        for (int i = 0; i < 2; ++i) { int R, C; stage_rc(tid * 16 + i * 8192, R, C); vo[0][i] = (unsigned)(R * ld + C) * 2u; vo[1][i] = (unsigned)((R + HALF) * ld + C) * 2u; }
    }
};
struct EpiP3a {
    static constexpr bool PERM = true;
    bf16* U; const bf16* MG; unsigned* pcu;
    __device__ __forceinline__ void operator()(const f32x4 (&acc)[2][2][4][2], const Unit& u, int wr, int wc, int fr, int fq) const {
        const int row0 = u.pm * BM + wr * 64 + fr, col0 = u.pn * BM + wc * 32 + 8 * fq;
        if (!u.aux) {
#pragma unroll
            for (int ai = 0; ai < 2; ++ai) {
                u32x4 g[4][2];
#pragma unroll
                for (int m = 0; m < 4; ++m)
#pragma unroll
                    for (int bj = 0; bj < 2; ++bj) g[m][bj] = *(const GAS u32x4*)(MG + (size_t)(row0 + ai * HALF + m * 16) * 2048 + col0 + bj * HALF);
#pragma unroll
                for (int m = 0; m < 4; ++m)
#pragma unroll
                    for (int bj = 0; bj < 2; ++bj) { const u32x4 gg = g[m][bj]; const f32x4 v0 = acc[ai][bj][m][0], v1 = acc[ai][bj][m][1];
                        u32x4 w; w.x = cvt_pk_bf16(v0[0] * bf_lo(gg.x), v0[1] * bf_hi(gg.x)); w.y = cvt_pk_bf16(v0[2] * bf_lo(gg.y), v0[3] * bf_hi(gg.y));
                        w.z = cvt_pk_bf16(v1[0] * bf_lo(gg.z), v1[1] * bf_hi(gg.z)); w.w = cvt_pk_bf16(v1[2] * bf_lo(gg.w), v1[3] * bf_hi(gg.w));
                        *(GAS u32x4*)(U + (size_t)(row0 + ai * HALF + m * 16) * D + col0 + bj * HALF) = w; }
            }
        } else {
            const __amdgpu_buffer_rsrc_t rsrc = __builtin_amdgcn_make_buffer_rsrc((void*)U, 0, (int)((size_t)T * D * 2), 0x00020000);
#pragma unroll
            for (int ai = 0; ai < 2; ++ai) {
                u32x4 g[4][2], pv[4][2];
#pragma unroll
                for (int m = 0; m < 4; ++m)
#pragma unroll
                    for (int bj = 0; bj < 2; ++bj) { g[m][bj] = *(const GAS u32x4*)(MG + (size_t)(row0 + ai * HALF + m * 16) * 2048 + 1024 + col0 + bj * HALF);
                        pv[m][bj] = *(const GAS u32x4*)(U + (size_t)(row0 + ai * HALF + m * 16) * D + col0 + bj * HALF); }
#pragma unroll
                for (int m = 0; m < 4; ++m)
#pragma unroll
                    for (int bj = 0; bj < 2; ++bj) { const u32x4 gg = g[m][bj], pp = pv[m][bj]; const f32x4 v0 = acc[ai][bj][m][0], v1 = acc[ai][bj][m][1];
                        u32x4 w; w.x = cvt_pk_bf16(bf_lo(pp.x) + v0[0] * bf_lo(gg.x), bf_hi(pp.x) + v0[1] * bf_hi(gg.x)); w.y = cvt_pk_bf16(bf_lo(pp.y) + v0[2] * bf_lo(gg.y), bf_hi(pp.y) + v0[3] * bf_hi(gg.y));
                        w.z = cvt_pk_bf16(bf_lo(pp.z) + v1[0] * bf_lo(gg.z), bf_hi(pp.z) + v1[1] * bf_hi(gg.z)); w.w = cvt_pk_bf16(bf_lo(pp.w) + v1[2] * bf_lo(gg.w), bf_hi(pp.w) + v1[3] * bf_hi(gg.w));
                        __builtin_amdgcn_raw_buffer_store_b128(w, rsrc, (int)(((size_t)(row0 + ai * HALF + m * 16) * D + col0 + bj * HALF) * 2), 0, 16); }
            }
            asm volatile("s_waitcnt vmcnt(0)" ::: "memory");
            if ((threadIdx.x & 63) == 0) __hip_atomic_fetch_add(pcu + 64 * u.pm, 1u, __ATOMIC_RELAXED, __HIP_MEMORY_SCOPE_AGENT);
        }
    }
};
struct SchedP3b {
    int G, c; const char* A; const char* B; unsigned* pcu; unsigned* tmo;
    __device__ __forceinline__ void a_ready(const Unit& u) const { panel_wait(pcu + 64 * u.pm, 32u, tmo); }
    __device__ __forceinline__ bool next(int i, Unit& u) const { if (!tile_order(i, G, c, T / BM, D / BM, u.pm, u.pn)) return false; u.aux = 0; u.A = A + (size_t)u.pm * BM * D * 2; u.B = B + (size_t)u.pn * BM * D * 2; return true; }
    __device__ __forceinline__ void lane_offs(const Unit&, int tid, unsigned (&vo)[2][2]) const {
#pragma unroll
        for (int i = 0; i < 2; ++i) { int R, C; stage_rc(tid * 16 + i * 8192, R, C); vo[0][i] = (unsigned)(R * D + C) * 2u; vo[1][i] = (unsigned)((R + HALF) * D + C) * 2u; }
    }
};
struct EpiP3b {
    static constexpr bool PERM = true;
    bf16* TB; unsigned* pct; const float* X;
    __device__ __forceinline__ void operator()(const f32x4 (&acc)[2][2][4][2], const Unit& u, int wr, int wc, int fr, int fq) const {
        const int row0 = u.pm * BM + wr * 64 + fr, col0 = u.pn * BM + wc * 32 + 8 * fq;
        const __amdgpu_buffer_rsrc_t rsrc = __builtin_amdgcn_make_buffer_rsrc((void*)TB, 0, (int)((size_t)T * 2048 * 2), 0x00020000);
#pragma unroll
        for (int ai = 0; ai < 2; ++ai) {
            f32x4 xv[4][2][2];
#pragma unroll
            for (int m = 0; m < 4; ++m)
#pragma unroll
                for (int bj = 0; bj < 2; ++bj)
#pragma unroll
                    for (int n = 0; n < 2; ++n) xv[m][bj][n] = *(const GAS f32x4*)(X + (size_t)(row0 + ai * HALF + m * 16) * D + col0 + bj * HALF + 4 * n);
#pragma unroll
            for (int m = 0; m < 4; ++m) { const size_t ro = (size_t)(row0 + ai * HALF + m * 16) * 2048 + col0;
#pragma unroll
                for (int bj = 0; bj < 2; ++bj) { const f32x4 v0 = acc[ai][bj][m][0] + xv[m][bj][0], v1 = acc[ai][bj][m][1] + xv[m][bj][1];
                    u32x4 w; w.x = cvt_pk_bf16(v0[0], v0[1]); w.y = cvt_pk_bf16(v0[2], v0[3]); w.z = cvt_pk_bf16(v1[0], v1[1]); w.w = cvt_pk_bf16(v1[2], v1[3]);
                    __builtin_amdgcn_raw_buffer_store_b128(w, rsrc, (int)((ro + bj * HALF) * 2), 0, 16); } }
        }
        asm volatile("s_waitcnt vmcnt(0)" ::: "memory");
        if ((threadIdx.x & 63) == 0) __hip_atomic_fetch_add(pct + 64 * u.pm, 1u, __ATOMIC_RELAXED, __HIP_MEMORY_SCOPE_AGENT);
    }
};

constexpr size_t TOK_E = 0, TOK_W = 131072, TOK_SLOT = 262144, TOK_LIST = 524288;
constexpr int RW_LD = 36;
__device__ __forceinline__ void p4_phase(Frame& F, const Args& a) {
    const float* g2 = a.in[15]; const float* wrg = a.in[16]; const float* brg = a.in[17]; const float* wre = a.in[18]; const float* bre = a.in[19];
    bf16* H2 = (bf16*)(a.ws + WS_D);
    int* tok_e = (int*)(a.ws + WS_TOK + TOK_E); float* tok_w = (float*)(a.ws + WS_TOK + TOK_W); int* tok_slot = (int*)(a.ws + WS_TOK + TOK_SLOT); int* list = (int*)(a.ws + WS_TOK + TOK_LIST);
    unsigned* cnt = (unsigned*)(F.ctl + CW_CNT);
    LAS float* W = (LAS float*)F.lds;
    LAS unsigned* lcnt = (LAS unsigned*)(F.lds + 148480); LAS unsigned* lbase = lcnt + 32; LAS unsigned* rec = lcnt + 64; LAS float* lbias = (LAS float*)(lcnt + 64 + 384);
    MK_TS(F, 1);
    if (F.tid < 64) lcnt[F.tid] = 0u;
    {
        f32x4 ve[16], vg[2];
#pragma unroll
        for (int q = 0; q < 16; ++q) ve[q] = *(const GAS f32x4*)(wre + (size_t)(F.tid + 512 * q) * 4);
#pragma unroll
        for (int q = 0; q < 2; ++q) vg[q] = *(const GAS f32x4*)(wrg + (size_t)(F.tid + 512 * q) * 4);
#pragma unroll
        for (int q = 0; q < 16; ++q) { const int pidx = F.tid + 512 * q, row = pidx >> 3; *(LAS f32x4*)(W + row * RW_LD + 4 * (row >> 5) + 4 + 4 * (pidx & 7)) = ve[q]; }
#pragma unroll
        for (int q = 0; q < 2; ++q) { const int row = F.tid + 512 * q; *(LAS f32x4*)(W + row * RW_LD + 4 * (row >> 5)) = vg[q]; }
        if (F.tid < NE) lbias[F.tid] = bre[F.tid];
    }
    LDS_WAIT();
    __syncthreads();
    MK_TS(F, 2);
    int ppm = 0, ppn = 0; tile_order(0, F.G, (int)blockIdx.x, T / BM, D / BM, ppm, ppn);
    panel_wait((unsigned*)(F.ctl + CW_PANT) + 64 * ppm, 32u, (unsigned*)(F.ctl + CW_TMO));
    MK_TS(F, 3);
    const int lane = F.lane, gw = ppm * BM + ppn * 64 + F.wave * 8; constexpr int NGW = 1;
    float gv[16];
#pragma unroll
    for (int m = 0; m < 8; ++m) { const f32x2 t2 = *(const GAS f32x2*)(g2 + 128 * m + 2 * lane); gv[2 * m] = t2.x; gv[2 * m + 1] = t2.y; }
    const float* xin = a.in[0]; const bf16* TBp = (const bf16*)a.out;
    const f32x4 brgv = *(const GAS f32x4*)brg;
    unsigned nt[8];
#pragma unroll
    for (int m = 0; m < 8; ++m) nt[m] = *(const GAS unsigned*)(TBp + (size_t)gw * 2048 + 128 * m + 2 * lane);
    auto token = [&](const int it) __attribute__((always_inline)) { const int t = gw + NGW * it;
        float y[16]; float ss = 0.f;
#pragma unroll
        for (int m = 0; m < 8; ++m) { y[2 * m] = bf_lo(nt[m]); y[2 * m + 1] = bf_hi(nt[m]); ss += y[2 * m] * y[2 * m] + y[2 * m + 1] * y[2 * m + 1]; }
        { const int tn = (t + NGW < T) ? t + NGW : t;
#pragma unroll
          for (int m = 0; m < 8; ++m) nt[m] = *(const GAS unsigned*)(TBp + (size_t)tn * 2048 + 128 * m + 2 * lane); }
        const float rstd = rsqrtf(wave_sum(ss) * (1.f / D) + 1e-6f);
#pragma unroll
        for (int m = 0; m < 8; ++m) { y[2 * m] *= rstd * gv[2 * m]; y[2 * m + 1] *= rstd * gv[2 * m + 1];
            *(GAS unsigned*)(H2 + (size_t)t * D + 128 * m + 2 * lane) = pk2(y[2 * m], y[2 * m + 1]); }
        f32x4 gl = {0.f, 0.f, 0.f, 0.f};
#pragma unroll
        for (int m = 0; m < 16; ++m) { const int k = 128 * (m >> 1) + 2 * lane + (m & 1); gl += y[m] * *(const LAS f32x4*)(W + k * RW_LD + 4 * (k >> 5)); }
#pragma unroll
        for (int j = 0; j < 4; ++j) gl[j] = wave_sum(gl[j]) + brgv[j];
        int gi = 0; float gm = gl[0];
#pragma unroll
        for (int j = 1; j < 4; ++j) if (gl[j] > gm) { gm = gl[j]; gi = j; }
        gi = __builtin_amdgcn_readfirstlane(gi);
        float gs = 0.f;
#pragma unroll
        for (int j = 0; j < 4; ++j) gs += __expf(gl[j] - gm);
        const float pg = 1.f / gs;
        f32x4 e0 = {0.f, 0.f, 0.f, 0.f}, e1 = {0.f, 0.f, 0.f, 0.f};
#pragma unroll
        for (int m = 0; m < 16; ++m) { const int k = 128 * (m >> 1) + 2 * lane + (m & 1); const LAS float* wr = W + k * RW_LD + 4 * (k >> 5) + 4 + 8 * gi; e0 += y[m] * *(const LAS f32x4*)wr; e1 += y[m] * *(const LAS f32x4*)(wr + 4); }
        float el[8];
#pragma unroll
        for (int j = 0; j < 4; ++j) { el[j] = wave_sum(e0[j]) + lbias[8 * gi + j]; el[4 + j] = wave_sum(e1[j]) + lbias[8 * gi + 4 + j]; }
        int i1 = 0, i2 = -1; float v1 = el[0], v2 = -3.0e38f;
#pragma unroll
        for (int j = 1; j < 8; ++j) { if (el[j] > v1) { v2 = v1; i2 = i1; v1 = el[j]; i1 = j; } else if (el[j] > v2) { v2 = el[j]; i2 = j; } }
        if (lane == 0) {
            const float ex = __expf(v2 - v1); const float w1 = pg / (1.f + ex), w2 = pg * ex / (1.f + ex);
            const int ea = gi * 8 + i1, eb = gi * 8 + i2;
            const unsigned sa = __hip_atomic_fetch_add(lcnt + ea, 1u, __ATOMIC_RELAXED, __HIP_MEMORY_SCOPE_WORKGROUP), sb = __hip_atomic_fetch_add(lcnt + eb, 1u, __ATOMIC_RELAXED, __HIP_MEMORY_SCOPE_WORKGROUP);
            LAS unsigned* rc = rec + 6 * (F.wave * 8 + it);
            rc[0] = (unsigned)ea; rc[1] = (unsigned)eb; rc[2] = sa; rc[3] = sb; rc[4] = __float_as_uint(w1); rc[5] = __float_as_uint(w2);
        }
    };
    token(0);
#pragma unroll 1
    for (int it = 1; it < 8; ++it) token(it);
    LDS_WAIT();
    __syncthreads();
    MK_TS(F, 4);
    if (F.tid < NE) { const unsigned n = lcnt[F.tid]; lbase[F.tid] = (n && !a.dry) ? atomicAdd(&cnt[F.tid], n) : 0u; }
    LDS_WAIT();
    __syncthreads();
    if (lane < 8) { const int t = gw + NGW * lane;
        if (t < T && !a.dry) { const LAS unsigned* rc = rec + 6 * (F.wave * 8 + lane); const unsigned ea = rc[0], eb = rc[1]; const unsigned sa = lbase[ea] + rc[2], sb = lbase[eb] + rc[3];
            tok_e[2 * t] = (int)ea; tok_e[2 * t + 1] = (int)eb; tok_w[2 * t] = __uint_as_float(rc[4]); tok_w[2 * t + 1] = __uint_as_float(rc[5]);
            tok_slot[2 * t] = (int)sa; tok_slot[2 * t + 1] = (int)sb; list[(size_t)ea * T + sa] = t; list[(size_t)eb * T + sb] = t; } }
    __syncthreads();
    MK_TS(F, 5);
}

constexpr int MT_CNT = 0, MT_OFF = 32, MT_TST = 65, MT_TE = 98;
constexpr size_t WS_HID = WS_E, WS_YB = WS_E + 33 * MiB;
__device__ __forceinline__ void moe_tables(Frame& F) {
    volatile LAS int* tb = (volatile LAS int*)(F.lds + MOE_TAB_OFF);
    if (F.tid < 64) {
        const int e = F.tid & 31;
        const int c = (int)__hip_atomic_load((unsigned*)(F.ctl + CW_CNT) + e, __ATOMIC_RELAXED, __HIP_MEMORY_SCOPE_AGENT);
        const int nt = (c + 255) >> 8;
        int off = c, ts = nt;
#pragma unroll
        for (int d = 1; d < 32; d <<= 1) { const int o = __shfl_up(off, d, 32), q = __shfl_up(ts, d, 32); if (e >= d) { off += o; ts += q; } }
        if (F.tid < 32) {
            tb[MT_CNT + e] = c; tb[MT_OFF + e] = off - c; tb[MT_TST + e] = ts - nt;
            for (int r = 0; r < nt; ++r) tb[MT_TE + ts - nt + r] = e;
            if (e == NE - 1) { tb[MT_OFF + NE] = off; tb[MT_TST + NE] = ts; }
        }
    }
    LDS_WAIT();
    __syncthreads();
}
struct SchedMoe {
    int G, c, second, ibase; const LAS int* tb; const char* Ab; const char* Wb; const int* list; unsigned* tcnt; unsigned* tmo;
    __device__ __forceinline__ bool next(int i, Unit& u) const {
        const int ntl = tb[MT_TST + NE]; int L;
        if (!second) { L = c + i * G; if (L >= ntl * 4) return false; }
        else {
            const int n1 = ntl * 4, r = n1 % G, nl = G - r, lc = c - r;
            if (lc >= 0) L = (i < 2) ? lc + i * nl : 2 * nl + lc + (i - 2) * G; else L = 2 * nl + (nl + c) + i * G;
            if (L >= n1) return false; }
        const int ti = L >> 2; u.pn = L & 3; const int e = tb[MT_TE + ti]; const int r = ti - tb[MT_TST + e];
        u.pm = ti; u.aux = (e << 8) | r;
        if (!second) { u.A = Ab; u.B = Wb + (size_t)e * EXP_STRIDE + (size_t)u.pn * BM * D * 2; }
        else { u.A = Ab + (size_t)(tb[MT_OFF + e] + 256 * r) * DE * 2; u.B = Wb + (size_t)e * EXP_STRIDE + EXP_DN_OFF + (size_t)u.pn * BM * DE * 2; }
        return true;
    }
    __device__ __forceinline__ void a_ready(const Unit& u) const {
        if (!second) return;
        if (threadIdx.x < 64) {
            unsigned polls = 0;
            while ((unsigned)__builtin_amdgcn_readfirstlane(__hip_atomic_load(tcnt + 64 * u.pm, __ATOMIC_RELAXED, __HIP_MEMORY_SCOPE_AGENT)) < 32u) {
                __builtin_amdgcn_s_sleep(2);
                if ((++polls & 1023u) == 0u) { if (__builtin_amdgcn_readfirstlane(__hip_atomic_load(tmo, __ATOMIC_RELAXED, __HIP_MEMORY_SCOPE_AGENT)) != 0u) break;
                    if (polls > (1u << 22)) { if (threadIdx.x == 0) __hip_atomic_store(tmo, 1u, __ATOMIC_RELAXED, __HIP_MEMORY_SCOPE_AGENT); break; } }
            }
            __builtin_amdgcn_fence(__ATOMIC_ACQUIRE, "agent");
            asm volatile("s_waitcnt vmcnt(0)" ::: "memory");
        }
        asm volatile("" ::: "memory"); __builtin_amdgcn_s_barrier(); asm volatile("" ::: "memory");
    }
    __device__ __forceinline__ void lane_offs(const Unit& u, int tid, unsigned (&vo)[2][2]) const {
        if (!second) {
            const int e = u.aux >> 8, r = u.aux & 255; const int cn = tb[MT_CNT + e];
#pragma unroll
            for (int i = 0; i < 2; ++i) { int R, C; stage_rc(tid * 16 + i * 8192, R, C);
#pragma unroll
                for (int h = 0; h < 2; ++h) { const int row = 256 * r + 128 * h + R; const int tok = list[(size_t)e * T + (row < cn ? row : 0)]; vo[h][i] = (unsigned)(tok * D + C) * 2u; } }
        } else {
#pragma unroll
            for (int i = 0; i < 2; ++i) { int R, C; stage_rc(tid * 16 + i * 8192, R, C); vo[0][i] = (unsigned)(R * DE + C) * 2u; vo[1][i] = (unsigned)((R + HALF) * DE + C) * 2u; }
        }
    }
};
struct EpiMoe1 {
    static constexpr bool PERM = true;
    bf16* HID; const LAS int* tb; unsigned* tcnt;
    __device__ __forceinline__ void operator()(const f32x4 (&acc)[2][2][4][2], const Unit& u, int wr, int wc, int fr, int fq) const {
        const int e = u.aux >> 8, r = u.aux & 255; const int cn = tb[MT_CNT + e], off = tb[MT_OFF + e];
        const int col0 = u.pn * 128 + wc * 32 + 8 * fq;
        const __amdgpu_buffer_rsrc_t rsrc = __builtin_amdgcn_make_buffer_rsrc((void*)HID, 0, (int)((2 * T + 256) * DE * 2), 0x00020000);
#pragma unroll
        for (int ai = 0; ai < 2; ++ai)
#pragma unroll
            for (int m = 0; m < 4; ++m) { const int row = 256 * r + ai * HALF + wr * 64 + m * 16 + fr;
                float hv[8];
#pragma unroll
                for (int n = 0; n < 2; ++n)
#pragma unroll
                    for (int j = 0; j < 4; ++j) { const float g = acc[ai][0][m][n][j], up = acc[ai][1][m][n][j]; hv[4 * n + j] = g * sigm(g) * up; }
                u32x4 w; w.x = cvt_pk_bf16(hv[0], hv[1]); w.y = cvt_pk_bf16(hv[2], hv[3]); w.z = cvt_pk_bf16(hv[4], hv[5]); w.w = cvt_pk_bf16(hv[6], hv[7]);
                if (row < cn) __builtin_amdgcn_raw_buffer_store_b128(w, rsrc, (int)(((size_t)(off + row) * DE + col0) * 2), 0, 16); }
        asm volatile("s_waitcnt vmcnt(0)" ::: "memory");
        if ((threadIdx.x & 63) == 0) __hip_atomic_fetch_add(tcnt + 64 * u.pm, 1u, __ATOMIC_RELAXED, __HIP_MEMORY_SCOPE_AGENT);
    }
};
struct EpiMoe2 {
    static constexpr bool PERM = true;
    bf16* YB; const LAS int* tb;
    __device__ __forceinline__ void operator()(const f32x4 (&acc)[2][2][4][2], const Unit& u, int wr, int wc, int fr, int fq) const {
        const int e = u.aux >> 8, r = u.aux & 255; const int cn = tb[MT_CNT + e], off = tb[MT_OFF + e];
        const int col0 = u.pn * BM + wc * 32 + 8 * fq;
#pragma unroll
        for (int ai = 0; ai < 2; ++ai)
#pragma unroll
            for (int m = 0; m < 4; ++m) { const int row = 256 * r + ai * HALF + wr * 64 + m * 16 + fr;
                if (row < cn) {
#pragma unroll
                    for (int bj = 0; bj < 2; ++bj) { const f32x4 v0 = acc[ai][bj][m][0], v1 = acc[ai][bj][m][1];
                        u32x4 w; w.x = cvt_pk_bf16(v0[0], v0[1]); w.y = cvt_pk_bf16(v0[2], v0[3]); w.z = cvt_pk_bf16(v1[0], v1[1]); w.w = cvt_pk_bf16(v1[2], v1[3]);
                        *(GAS u32x4*)(YB + (size_t)(off + row) * D + col0 + bj * HALF) = w; } } }
    }
};
__device__ __forceinline__ void p6_phase(Frame& F, const Args& a) {
    const LAS int* tb = (const LAS int*)(F.lds + MOE_TAB_OFF);
    const int* tok_e = (const int*)(a.ws + WS_TOK + TOK_E); const float* tok_w = (const float*)(a.ws + WS_TOK + TOK_W); const int* tok_slot = (const int*)(a.ws + WS_TOK + TOK_SLOT);
    const bf16* YB = (const bf16*)(a.ws + WS_YB); float* out = a.out; const float* xin = a.in[0]; const bf16* TBp = (const bf16*)a.out;
    const int lane = F.lane, gw = F.vcu * NWAVES + F.wave, NGW = F.G * NWAVES;
    const int tmine = gw + NGW * (lane & 7);
    float mw1 = 0.f, mw2 = 0.f; unsigned mp1 = 0u, mp2 = 0u;
    if (tmine < T) { const int e1 = tok_e[2 * tmine], e2 = tok_e[2 * tmine + 1]; mw1 = tok_w[2 * tmine]; mw2 = tok_w[2 * tmine + 1];
        mp1 = (unsigned)(tb[MT_OFF + e1] + tok_slot[2 * tmine]); mp2 = (unsigned)(tb[MT_OFF + e2] + tok_slot[2 * tmine + 1]); }
    static_assert(T == 2048 * 8, "P6 assumes 8 tokens per wave on a 256 x 8 wave grid");
#pragma unroll 1
    for (int i0 = 0; i0 < 8; i0 += 4) {
        u32x2 tv[4][4], ya[4][4], yb[4][4]; float w1[4], w2[4];
#pragma unroll
        for (int i = 0; i < 4; ++i) { const int t = gw + NGW * (i0 + i); const size_t p1 = __shfl(mp1, i0 + i), p2 = __shfl(mp2, i0 + i); w1[i] = __shfl(mw1, i0 + i); w2[i] = __shfl(mw2, i0 + i);
#pragma unroll
            for (int j = 0; j < 4; ++j) { const int c = 4 * (lane + 64 * j);
                tv[i][j] = *(const GAS u32x2*)(TBp + (size_t)t * 2048 + c);
                ya[i][j] = *(const GAS u32x2*)(YB + p1 * D + c); yb[i][j] = *(const GAS u32x2*)(YB + p2 * D + c); } }
#pragma unroll
        for (int i = 0; i < 4; ++i) { const int t = gw + NGW * (i0 + i);
#pragma unroll
            for (int j = 0; j < 4; ++j) { const int c = 4 * (lane + 64 * j); f32x4 o;
                o[0] = bf_lo(tv[i][j].x) + w1[i] * bf_lo(ya[i][j].x) + w2[i] * bf_lo(yb[i][j].x); o[1] = bf_hi(tv[i][j].x) + w1[i] * bf_hi(ya[i][j].x) + w2[i] * bf_hi(yb[i][j].x);
                o[2] = bf_lo(tv[i][j].y) + w1[i] * bf_lo(ya[i][j].y) + w2[i] * bf_lo(yb[i][j].y); o[3] = bf_hi(tv[i][j].y) + w1[i] * bf_hi(ya[i][j].y) + w2[i] * bf_hi(yb[i][j].y);
                if (t < T && !a.dry) *(GAS f32x4*)(out + (size_t)t * D + c) = o; else asm volatile("" :: "v"(o)); } }
    }
}

__global__ void __launch_bounds__(NWAVES * 64, 2) fwd(Args args) {
    extern __shared__ __attribute__((aligned(16))) unsigned char lds[];
    Frame F;
    F.lds = (LAS unsigned char*)lds;
    F.MISC = (volatile LAS unsigned*)(F.lds + MISC_OFF);
    F.tid = threadIdx.x; F.lane = F.tid & 63; F.wave = __builtin_amdgcn_readfirstlane(F.tid >> 6);
    F.G = gridDim.x; { const int bx = blockIdx.x; F.vcu = (F.G % 8 == 0) ? (bx % 8) * (F.G / 8) + bx / 8 : bx; }
    unsigned char* ws = args.ws;
    F.ctl = (gu32*)(ws + WS_CTL);
    for (int u = F.tid; u < (LDS_BYTES - LDSCTL_OFF) / 4; u += NWAVES * 64) ((LAS unsigned*)(F.lds + LDSCTL_OFF))[u] = 0u;
    __syncthreads();
    MK_TS(F, 10);
    const int lo = args.ph_lo, hi = args.ph_hi;
    XcdBarrier bar; bar.bar = (unsigned*)(F.ctl + CW_BAR) + args.li * XCD_BAR_WORDS; bar.x = 0; bar.st = nullptr;
    if (hi - lo > 1) bar = xcd_barrier_post((unsigned*)(F.ctl + CW_BAR) + args.li * XCD_BAR_WORDS, F.MISC + 8);
#define IN(k) (lo <= (k) && (k) < hi)
#define SEAM_CUT(k) do { } while (0)
#define SEAM(k) do { if (IN(k) && (IN((k) + 1) || ((k) == 8 && IN(10)) || ((k) == 3 && IN(5)))) xcd_barrier(bar); } while (0)

    if (IN(0)) { p0_prologue(F, args); }
    MK_TS(F, 11);
    SEAM(0);
    MK_TS(F, 12);
    if (IN(1)) {
        SchedP1 S{F.G, (int)blockIdx.x, (const char*)(ws + WS_D), (const char*)(ws + WS_WIN_T)};
        EpiP1 E{(bf16*)(ws + WS_E), (bf16*)args.out, (float*)(ws + WS_GM), args.in[13], args.in[9]};
        const bool early = ((blockIdx.x >> 3) & 1) == 0;
        const int grank = (int)(blockIdx.x >> 4) * 8 + (int)(blockIdx.x & 7);
        if (early) { p0_experts(F, args, 0, MK_EXP_SPLIT_A, grank, 128); p0_experts(F, args, 12288, EXP_ITEMS, grank, 128); }
        gemm_phase<EpiP1, SchedP1>(F.lds, D, S, E);
        if (!early) p0_experts(F, args, MK_EXP_SPLIT_A, MK_EXP_SPLIT_B, grank, 128);
    }
    MK_TS(F, 13);
    SEAM(1);
    MK_TS(F, 14);
#if MK_NPH > 2
    if (IN(2)) { p2a_phase(F, args); }
    MK_TS(F, 15);
    SEAM(2);
    MK_TS(F, 16);
#endif
#if MK_NPH > 3
    if (IN(3)) { p2m_phase(F, args); }
    MK_TS(F, 17);
    SEAM(3);
    MK_TS(F, 18);
#endif
#if MK_NPH > 5
    if (IN(5)) {
        unsigned* pcnt = (unsigned*)(F.ctl + CW_PAN);
        {
            int pm, pn; tile_order(0, F.G, (int)blockIdx.x, T / BM, D / BM, pm, pn);
            if ((pm & 1) && MK_EXP_SPLIT_B < MK_EXP_SPLIT_C && !args.dry) p0_experts(F, args, MK_EXP_SPLIT_B, MK_EXP_SPLIT_C, (pm >> 1) * 4 + pn, 128);
        }
        if (!args.dry) { int pm, pn; if (tile_order(0, F.G, (int)blockIdx.x, T / BM, D / BM, pm, pn)) p2b_rows(F, args, pm * BM + pn * 64, pcnt + 64 * pm); }
        SchedP3a S{F.G, (int)blockIdx.x, (const char*)(ws + WS_E), (const char*)(ws + WS_WA_T), (const char*)(ws + WS_WM_T), (const char*)(ws + WS_YA), pcnt, (unsigned*)(F.ctl + CW_TMO)};
        EpiP3a E{(bf16*)(ws + WS_D), (const bf16*)args.out, (unsigned*)(F.ctl + CW_PANU)};
        gemm_phase<EpiP3a, SchedP3a>(F.lds, 512, S, E);
    }
    MK_TS(F, 19);
    SEAM_CUT(5);
    if (IN(6)) {
        {
            int pm, pn; tile_order(0, F.G, (int)blockIdx.x, T / BM, D / BM, pm, pn);
            if (!(pm & 1) && MK_EXP_SPLIT_C < MK_EXP_SPLIT_D) p0_experts(F, args, MK_EXP_SPLIT_C, MK_EXP_SPLIT_D, (pm >> 1) * 4 + pn, 128);
        }
        SchedP3b S{F.G, (int)blockIdx.x, (const char*)(ws + WS_D), (const char*)(ws + WS_WOUT_T), (unsigned*)(F.ctl + CW_PANU), (unsigned*)(F.ctl + CW_TMO)};
        EpiP3b E{(bf16*)args.out, (unsigned*)(F.ctl + CW_PANT), args.in[0]};
        gemm_phase<EpiP3b, SchedP3b>(F.lds, D, S, E);
    }
    MK_TS(F, 20);
    SEAM_CUT(6);
#endif
#if MK_NPH > 7
    if (IN(7)) {
        {
            int pm, pn; tile_order(0, F.G, (int)blockIdx.x, T / BM, D / BM, pm, pn);
            if ((pm & 1) && MK_EXP_SPLIT_D < 12288 && !args.dry) p0_experts(F, args, MK_EXP_SPLIT_D, 12288, (pm >> 1) * 4 + pn, 128);
        }
        p4_phase(F, args); }
    MK_TS(F, 21);
    SEAM(7);
    MK_TS(F, 22);
    if (IN(8)) {
        moe_tables(F);
        const LAS int* tb = (const LAS int*)(F.lds + MOE_TAB_OFF);
        unsigned* tcnt = (unsigned*)(F.ctl + CW_TILE); unsigned* tmo = (unsigned*)(F.ctl + CW_TMO);
        const int n1 = tb[MT_TST + NE] * 4; const int i1 = (F.vcu < n1) ? (n1 - F.vcu + F.G - 1) / F.G : 0;
        {   SchedMoe S{F.G, F.vcu, 0, 0, tb, (const char*)(ws + WS_D), (const char*)(ws + WS_EXP), (const int*)(ws + WS_TOK + TOK_LIST), tcnt, tmo};
            EpiMoe1 E{(bf16*)(ws + WS_HID), tb, tcnt};
            gemm_phase<EpiMoe1, SchedMoe>(F.lds, D, S, E); }
        {   SchedMoe S{F.G, F.vcu, 1, i1, tb, (const char*)(ws + WS_HID), (const char*)(ws + WS_EXP), (const int*)(ws + WS_TOK + TOK_LIST), tcnt, tmo};
            EpiMoe2 E{(bf16*)(ws + WS_YB), tb};
            gemm_phase<EpiMoe2, SchedMoe>(F.lds, DE, S, E); }
    }
    MK_TS(F, 23);
    SEAM(8);
    MK_TS(F, 24);
    if (IN(10)) { moe_tables(F); p6_phase(F, args); }
#endif
    MK_TS(F, 25);
#ifdef MK_TL_SEL
    if (blockIdx.x == MK_TL_WG && F.tid == 0) { volatile LAS unsigned* sl = (volatile LAS unsigned*)(F.lds + LDSCTL_OFF + 3200); const unsigned v = sl[MK_TL_SEL] - sl[MK_TL_SEL - 1];
        const unsigned long long t0 = __builtin_amdgcn_s_memrealtime(); const unsigned long long dt = (unsigned long long)v * MK_TL_AMP;
        while (__builtin_amdgcn_s_memrealtime() - t0 < dt) __builtin_amdgcn_s_sleep(8); }
#endif
#undef IN
#undef SEAM
}
}

extern "C" void kernel_launch(void* const* d_in, const int* in_sizes, int n_in, void* d_out, int out_size, void* d_ws, size_t ws_size, hipStream_t stream) {
    static int grid = 0;
    if (grid == 0) {
        int dev = 0, cus = 0;
        if (n_in != 23 || out_size != mk::T * mk::D || ws_size < mk::WS_END) { fprintf(stderr, "kernel_launch: unexpected problem (n_in %d, out %d, ws %zu < %zu)\n", n_in, out_size, ws_size, (size_t)mk::WS_END); grid = -1; return; }
        if (hipGetDevice(&dev) != hipSuccess || hipDeviceGetAttribute(&cus, hipDeviceAttributeMultiprocessorCount, dev) != hipSuccess) { grid = -1; return; }
        if (hipFuncSetAttribute((const void*)mk::fwd, hipFuncAttributeMaxDynamicSharedMemorySize, mk::LDS_BYTES) != hipSuccess) { fprintf(stderr, "kernel_launch: hipFuncSetAttribute failed\n"); grid = -1; return; }
        int per_cu = 0;
        if (hipOccupancyMaxActiveBlocksPerMultiprocessor(&per_cu, (const void*)mk::fwd, mk::NWAVES * 64, mk::LDS_BYTES) != hipSuccess || per_cu < 1) { fprintf(stderr, "kernel_launch: occupancy query reports %d workgroups per CU\n", per_cu); }
        (void)hipGetLastError();
        grid = cus;
        if (grid != 256) { fprintf(stderr, "kernel_launch: built for a 256-CU device (one 256x256 merge/out-GEMM tile and 64 router rows per workgroup); found %d CUs; nothing launched\n", grid); grid = -1; return; }
    }
    if (grid < 0) return;
    (void)hipMemsetAsync((char*)d_ws + mk::WS_CTL, 0, mk::CTL_ZERO_BYTES, stream);
    mk::Args a{};
    for (int i = 0; i < 23; ++i) a.in[i] = (const float*)d_in[i];
    a.out = (float*)d_out; a.ws = (unsigned char*)d_ws;
    const int launches[][3] = {MK_LAUNCHES};
    for (int li = 0; li < (int)(sizeof(launches) / sizeof(launches[0])); ++li) {
        a.ph_lo = launches[li][0]; a.ph_hi = launches[li][1]; a.li = li; a.dry = launches[li][2];
        hipLaunchKernelGGL(mk::fwd, dim3(grid), dim3(mk::NWAVES * 64), mk::LDS_BYTES, stream, a);
    }
}
```
